# Optimizing an MI355X kernel written in HIP

```python
import math
import jax, jax.numpy as jnp
from jax import lax
import numpy as np

D_MODEL = 1024
BATCH = 16
SEQ = 2048
DEPTH = 1

D_MIX = D_MODEL
GM_WIDTH = D_MIX // 2
GM_HEAD_DIM = 64
GM_HEADS = GM_WIDTH // GM_HEAD_DIM
GM_CHUNK = 128
SSM_WIDTH = D_MIX - GM_WIDTH
SSM_HEAD_DIM = 64
SSM_HEADS = SSM_WIDTH // SSM_HEAD_DIM
SSM_GROUPS = 2
SSM_STATE = 128
SSM_CONV = 4
SSM_CHUNK = 128
SSM_CONV_CH = SSM_WIDTH + 2 * SSM_GROUPS * SSM_STATE
D_FF = 4 * D_MODEL
EPS = 1e-6

IN_COLS = 2 * GM_WIDTH + SSM_WIDTH + SSM_CONV_CH + SSM_HEADS
SPLITS = (GM_WIDTH, 2 * GM_WIDTH, 2 * GM_WIDTH + SSM_WIDTH,
          2 * GM_WIDTH + SSM_WIDTH + SSM_CONV_CH)

kernel_name = "hybrid_gmlp_ssd_sandwich_block"


def rms_norm(x, w):
    xf = x.astype(jnp.float32)
    y = xf * lax.rsqrt(jnp.mean(xf * xf, axis=-1, keepdims=True) + EPS)
    return (y * w.astype(jnp.float32)).astype(x.dtype)


def layer_norm(x, w, b):
    xf = x.astype(jnp.float32)
    mu = jnp.mean(xf, axis=-1, keepdims=True)
    var = jnp.mean(jnp.square(xf - mu), axis=-1, keepdims=True)
    y = (xf - mu) * lax.rsqrt(var + EPS)
    return (y * w.astype(jnp.float32) + b.astype(jnp.float32)).astype(x.dtype)


def gmlp_mixer(u, v, ln_w, ln_b, w_s, b_s):
    bsz, L, _ = u.shape
    nc = L // GM_CHUNK
    u = jax.nn.gelu(u)
    v = jax.nn.gelu(v).reshape(bsz, L, GM_HEADS, GM_HEAD_DIM)
    v = layer_norm(v, ln_w, ln_b).reshape(bsz, nc, GM_CHUNK, GM_HEADS, GM_HEAD_DIM)
    causal = jnp.tril(jnp.ones((GM_CHUNK, GM_CHUNK), dtype=bool))
    w = jnp.where(causal[None], w_s, jnp.zeros((), w_s.dtype))
    mixed = jnp.einsum("hts,bcshp->bcthp", w, v) + b_s.T[None, None, :, :, None]
    return u * mixed.reshape(bsz, L, GM_WIDTH)


def causal_depthwise_conv(x, w, b):
    ch = x.shape[-1]
    y = lax.conv_general_dilated(
        x, w[:, None, :].astype(x.dtype), window_strides=(1,),
        padding=((SSM_CONV - 1, 0),), dimension_numbers=("NWC", "WIO", "NWC"),
        feature_group_count=ch)
    return y + b


def ssd_chunked(x, dt, a, bmat, cmat, d_skip):
    bsz, L = x.shape[0], x.shape[1]
    nc = L // SSM_CHUNK
    R = SSM_HEADS // SSM_GROUPS
    Q = SSM_CHUNK
    x = x.astype(jnp.float32).reshape(bsz, nc, Q, SSM_GROUPS, R, SSM_HEAD_DIM)
    dt = dt.astype(jnp.float32).reshape(bsz, nc, Q, SSM_GROUPS, R)
    bmat = bmat.astype(jnp.float32).reshape(bsz, nc, Q, SSM_GROUPS, SSM_STATE)
    cmat = cmat.astype(jnp.float32).reshape(bsz, nc, Q, SSM_GROUPS, SSM_STATE)
    a = a.astype(jnp.float32).reshape(SSM_GROUPS, R)
    d_skip = d_skip.astype(jnp.float32).reshape(SSM_GROUPS, R)

    a_cs = jnp.cumsum(dt * a, axis=2)
    x_dt = x * dt[..., None]

    causal = jnp.tril(jnp.ones((Q, Q), dtype=bool))[:, :, None, None]
    seg = a_cs[:, :, :, None] - a_cs[:, :, None, :]
    decay = jnp.exp(jnp.where(causal, seg, -jnp.inf))
    cb = jnp.einsum("bclgn,bcsgn->bclsg", cmat, bmat)
    y_diag = jnp.einsum("bclsg,bclsgr,bcsgrp->bclgrp", cb, decay, x_dt)

    decay_to_end = jnp.exp(a_cs[:, :, -1:] - a_cs)
    states = jnp.einsum("bcsgn,bcsgr,bcsgrp->bcgrpn", bmat, decay_to_end, x_dt)
    chunk_decay = jnp.exp(a_cs[:, :, -1])

    def step(h, inp):
        s, dcy = inp
        return h * dcy[..., None, None] + s, h
    h0 = jnp.zeros((bsz, SSM_GROUPS, R, SSM_HEAD_DIM, SSM_STATE), jnp.float32)
    _, prev = lax.scan(step, h0, (jnp.moveaxis(states, 1, 0), jnp.moveaxis(chunk_decay, 1, 0)))
    prev = jnp.moveaxis(prev, 0, 1)

    y_off = jnp.einsum("bclgn,bcgrpn,bclgr->bclgrp", cmat, prev, jnp.exp(a_cs))
    y = y_diag + y_off + d_skip[:, :, None] * x
    return y.reshape(bsz, L, SSM_HEADS * SSM_HEAD_DIM)


def mamba2_mixer(z, xbc, dt_raw, conv_w, conv_b, dt_bias, a_log, d_skip, norm_w):
    bsz, L, _ = z.shape
    xbc = jax.nn.silu(causal_depthwise_conv(xbc, conv_w, conv_b))
    xs = xbc[..., :SSM_WIDTH].reshape(bsz, L, SSM_HEADS, SSM_HEAD_DIM)
    bmat = xbc[..., SSM_WIDTH:SSM_WIDTH + SSM_GROUPS * SSM_STATE].reshape(bsz, L, SSM_GROUPS, SSM_STATE)
    cmat = xbc[..., SSM_WIDTH + SSM_GROUPS * SSM_STATE:].reshape(bsz, L, SSM_GROUPS, SSM_STATE)
    dt = jax.nn.softplus(dt_raw.astype(jnp.float32) + dt_bias.astype(jnp.float32))
    a = -jnp.exp(a_log.astype(jnp.float32))
    y = ssd_chunked(xs, dt, a, bmat, cmat, d_skip)
    y = y * jax.nn.silu(z.astype(jnp.float32))
    y = y.reshape(bsz, L, SSM_GROUPS, SSM_WIDTH // SSM_GROUPS)
    y = y * lax.rsqrt(jnp.mean(y * y, axis=-1, keepdims=True) + EPS)
    y = y.reshape(bsz, L, SSM_WIDTH) * norm_w.astype(jnp.float32)
    return y.astype(z.dtype)


def setup_inputs(seed: int = 0) -> dict:
    key = jax.random.key(seed)
    ks = jax.random.split(key, 24)
    f32 = jnp.float32

    def gain(k, shape):
        return 1.0 + 0.02 * jax.random.normal(k, shape, f32)

    x = jax.random.normal(ks[0], (BATCH, SEQ, D_MODEL), f32)
    norm_mix_pre = gain(ks[1], (DEPTH, D_MODEL))
    w_in = jax.random.normal(ks[2], (DEPTH, D_MODEL, IN_COLS), f32) * D_MODEL ** -0.5
    gm_ln_w = gain(ks[3], (DEPTH, GM_HEADS, GM_HEAD_DIM))
    gm_ln_b = 0.02 * jax.random.normal(ks[4], (DEPTH, GM_HEADS, GM_HEAD_DIM), f32)
    gm_w_s = jax.random.normal(ks[5], (DEPTH, GM_HEADS, GM_CHUNK, GM_CHUNK), f32) * GM_CHUNK ** -0.5
    gm_b_s = gain(ks[6], (DEPTH, GM_HEADS, GM_CHUNK))
    conv_w = jax.random.normal(ks[7], (DEPTH, SSM_CONV, SSM_CONV_CH), f32) * SSM_CONV ** -0.5
    conv_b = 0.02 * jax.random.normal(ks[8], (DEPTH, SSM_CONV_CH), f32)
    dt_min, dt_max = 1e-3, 1e-1
    u = jax.random.uniform(ks[9], (DEPTH, SSM_HEADS), f32)
    dt0 = jnp.maximum(jnp.exp(u * (math.log(dt_max) - math.log(dt_min)) + math.log(dt_min)), 1e-4)
    dt_bias = dt0 + jnp.log(-jnp.expm1(-dt0))
    a_log = jnp.log(jax.random.uniform(ks[10], (DEPTH, SSM_HEADS), f32, 1.0, 16.0))
    d_skip = gain(ks[11], (DEPTH, SSM_HEADS))
    ssm_norm_w = gain(ks[12], (DEPTH, SSM_WIDTH))
    w_out = jax.random.normal(ks[13], (DEPTH, D_MIX, D_MODEL), f32) * D_MIX ** -0.5
    norm_mix_post = gain(ks[14], (DEPTH, D_MODEL))
    norm_ffn_pre = gain(ks[15], (DEPTH, D_MODEL))
    w_up = jax.random.normal(ks[16], (DEPTH, D_MODEL, D_FF), f32) * D_MODEL ** -0.5
    w_down = jax.random.normal(ks[17], (DEPTH, D_FF, D_MODEL), f32) * D_FF ** -0.5
    norm_ffn_post = gain(ks[18], (DEPTH, D_MODEL))
    return {"x": x, "norm_mix_pre": norm_mix_pre, "w_in": w_in, "gm_ln_w": gm_ln_w,
            "gm_ln_b": gm_ln_b, "gm_w_s": gm_w_s, "gm_b_s": gm_b_s, "conv_w": conv_w,
            "conv_b": conv_b, "dt_bias": dt_bias, "a_log": a_log, "d_skip": d_skip,
            "ssm_norm_w": ssm_norm_w, "w_out": w_out, "norm_mix_post": norm_mix_post,
            "norm_ffn_pre": norm_ffn_pre, "w_up": w_up, "w_down": w_down,
            "norm_ffn_post": norm_ffn_post}


def reference(x, norm_mix_pre, w_in, gm_ln_w, gm_ln_b, gm_w_s, gm_b_s, conv_w, conv_b,
              dt_bias, a_log, d_skip, ssm_norm_w, w_out, norm_mix_post, norm_ffn_pre,
              w_up, w_down, norm_ffn_post):
    for i in range(DEPTH):
        h = rms_norm(x, norm_mix_pre[i])
        proj = jnp.einsum("bld,dk->blk", h, w_in[i])
        u_a, v_a, z_b, xbc_b, dt_b = jnp.split(proj, SPLITS, axis=-1)
        y_a = gmlp_mixer(u_a, v_a, gm_ln_w[i], gm_ln_b[i], gm_w_s[i], gm_b_s[i])
        y_b = mamba2_mixer(z_b, xbc_b, dt_b, conv_w[i], conv_b[i], dt_bias[i], a_log[i],
                           d_skip[i], ssm_norm_w[i])
        mix = jnp.concatenate([y_a, y_b], axis=-1)
        x = x + rms_norm(jnp.einsum("blk,kd->bld", mix, w_out[i]), norm_mix_post[i])
        h = rms_norm(x, norm_ffn_pre[i])
        f = jnp.square(jax.nn.relu(jnp.einsum("bld,df->blf", h, w_up[i])))
        x = x + rms_norm(jnp.einsum("blf,fd->bld", f, w_down[i]), norm_ffn_post[i])
    return x
```

```cpp
#include <hip/hip_runtime.h>
#include <hip/hip_cooperative_groups.h>
#include <cstdio>
#include <cstdint>
namespace pg8 {
#define PG8_LAS __attribute__((address_space(3)))
typedef unsigned short bf16_t;
typedef short bf16x8 __attribute__((ext_vector_type(8)));
typedef float f32x4 __attribute__((ext_vector_type(4)));
typedef unsigned u32x4 __attribute__((ext_vector_type(4)));
constexpr int BM = 256, BK = 64, HALF = 128, HTB = HALF * BK * 2  , STAGE_BYTES = 8 * HTB, NXCD = 8, WGM = 8;

__host__ __device__ __forceinline__ int lds_byte(int r, int c) { const int st = (r >> 4) * 2 + (c >> 5), rr = r & 15, cc = c & 31, ob = rr * 64 + cc * 2; return st * 1024 + (ob ^ (((ob >> 9) & 1) << 5)); }
__host__ __device__ __forceinline__ void stage_rc(int b, int& R, int& C) { const int st = b / 1024, sb = b % 1024, swz = sb ^ (((sb >> 9) & 1) << 5); R = (st >> 1) * 16 + swz / 64; C = (st & 1) * 32 + (swz % 64) / 2; }
__host__ __device__ __forceinline__ int perm32(int rho) { const int n = rho >> 4, i = rho & 15; return 8 * (i >> 2) + 4 * n + (i & 3); }

struct Unit { int pm, pn; };
struct Gemm { const bf16_t* A; const bf16_t* Bt; int M, N, K; };

struct StaticOrder {
    int nM, nN, nwg, G, c;
    __host__ __device__ void init(int M, int N, int G_, int c_) { nM = M / BM; nN = N / BM; nwg = nM * nN; G = G_; c = c_; }
    __host__ __device__ bool next(int i, Unit& u) const {
        const long L = (long)i * G + c; if (L >= nwg) return false;
        int wgid = (int)L; { const int q = nwg / NXCD, r = nwg % NXCD, xcd = wgid % NXCD, off = wgid / NXCD; wgid = (xcd < r ? xcd * (q + 1) : r * (q + 1) + (xcd - r) * q) + off; }
        const int nig = WGM * nN, gid = wgid / nig, fm = gid * WGM, gsz = (nM - fm) < WGM ? (nM - fm) : WGM;
        u.pm = fm + ((wgid % nig) % gsz); u.pn = (wgid % nig) / gsz; return true;
    }
    __device__ __forceinline__ void a_ready(const Unit&) const {}
    __device__ __forceinline__ void done(const Unit&) const {}
};

struct RoundOrder {
    StaticOrder so; int r;
    __host__ __device__ bool next(int i, Unit& u) const { return i == 0 && so.next(r, u); }
    __device__ __forceinline__ void a_ready(const Unit&) const {}
    __device__ __forceinline__ void done(const Unit&) const {}
};
__device__ __forceinline__ unsigned cvt_pk_bf16(float lo, float hi) { unsigned r; asm volatile("v_cvt_pk_bf16_f32 %0, %1, %2" : "=v"(r) : "v"(lo), "v"(hi)); return r; }
typedef float f32x2 __attribute__((ext_vector_type(2)));
__device__ __forceinline__ f32x2 gelu_pk(f32x2 v) {
    const f32x2 av = __builtin_elementwise_abs(v), d = av * 0.2316418882f + 1.0f;
    f32x2 t; t.x = __builtin_amdgcn_rcpf(d.x); t.y = __builtin_amdgcn_rcpf(d.y);
    f32x2 q = t * 0.5307027145f + (-0.7265760135f); q = q * t + 0.7107068705f; q = q * t + (-0.142248368f); q = q * t + 0.127414796f; q = q * t;
    const f32x2 s = (v * v) * (-0.72134752044f);
    f32x2 e; e.x = __builtin_amdgcn_exp2f(s.x); e.y = __builtin_amdgcn_exp2f(s.y);
    const f32x2 m = v * (q * e), r = v - m;
    f32x2 o; o.x = v.x < 0.f ? m.x : r.x; o.y = v.y < 0.f ? m.y : r.y; return o;
}

template <int ACT  > struct EpiBf16 {
    static constexpr bool PERM = true, AFTER_DRAIN = false, KSCALE = false; static_assert(ACT == 0 || ACT == 1 || ACT == 2, "EpiBf16: ACT 0 none, 1 gelu_pk, 2 relu^2");
    bf16_t* O; int ldc; const float* bias; int split_cols; size_t split_stride; float scale0;
    __device__ __forceinline__ void operator()(const f32x4 (&acc)[2][2][4][2], const Unit& u, int wr, int wc, int fr, int fq) const {
        const int row0 = u.pm * BM + wr * 64 + fr; int colt = u.pn * BM; bf16_t* base = O;
        float sc = 1.f; if (split_cols) { const int t = colt / split_cols; base += (size_t)t * split_stride; colt -= t * split_cols; if (t == 0) sc = scale0; }
        const int col0 = colt + wc * 32 + 8 * fq, bcol0 = u.pn * BM + wc * 32 + 8 * fq;
        f32x4 bv[2][2];
#pragma unroll
        for (int bj = 0; bj < 2; ++bj)
#pragma unroll
            for (int n = 0; n < 2; ++n) bv[bj][n] = bias ? *(const f32x4*)(bias + bcol0 + bj * HALF + 4 * n) : (f32x4){0.f, 0.f, 0.f, 0.f};
#pragma unroll
        for (int ai = 0; ai < 2; ++ai)
#pragma unroll
            for (int m = 0; m < 4; ++m) { bf16_t* rowp = base + (size_t)(row0 + ai * HALF + m * 16) * ldc + col0;
#pragma unroll
                for (int bj = 0; bj < 2; ++bj) { f32x4 v0 = acc[ai][bj][m][0] + bv[bj][0], v1 = acc[ai][bj][m][1] + bv[bj][1];
                    if (ACT == 1) { f32x2 a = gelu_pk((f32x2){v0[0], v0[1]}), b = gelu_pk((f32x2){v0[2], v0[3]}), c = gelu_pk((f32x2){v1[0], v1[1]}), d = gelu_pk((f32x2){v1[2], v1[3]});
                        v0 = (f32x4){a.x, a.y, b.x, b.y}; v1 = (f32x4){c.x, c.y, d.x, d.y}; }
                    if (ACT == 2) { v0 = __builtin_elementwise_max(v0, (f32x4){0.f, 0.f, 0.f, 0.f}); v1 = __builtin_elementwise_max(v1, (f32x4){0.f, 0.f, 0.f, 0.f}); v0 = v0 * v0; v1 = v1 * v1; }
                    v0 = v0 * sc; v1 = v1 * sc; u32x4 w; w.x = cvt_pk_bf16(v0[0], v0[1]); w.y = cvt_pk_bf16(v0[2], v0[3]); w.z = cvt_pk_bf16(v1[0], v1[1]); w.w = cvt_pk_bf16(v1[2], v1[3]);
                    *(u32x4*)(rowp + bj * HALF) = w; } }
    }
};

struct EpiF32 {
    static constexpr bool PERM = false, AFTER_DRAIN = false, KSCALE = false;
    float* O; int ldc;
    __device__ __forceinline__ void operator()(const f32x4 (&acc)[2][2][4][2], const Unit& u, int wr, int wc, int fr, int fq) const {
        const int col0 = u.pn * BM + wc * 32 + 4 * fq;
#pragma unroll
        for (int ai = 0; ai < 2; ++ai)
#pragma unroll
            for (int m = 0; m < 4; ++m) { const size_t off = (size_t)(u.pm * BM + ai * HALF + wr * 64 + m * 16 + fr) * ldc + col0;
#pragma unroll
                for (int bj = 0; bj < 2; ++bj)
#pragma unroll
                    for (int n = 0; n < 2; ++n) *(f32x4*)(O + off + bj * HALF + n * 16) = acc[ai][bj][m][n]; }
    }
};

struct EpiBf16K {
    static constexpr bool PERM = true, AFTER_DRAIN = false, KSCALE = true;
    bf16_t* O; int ldc; const float* ssq;
    PG8_LAS unsigned char* tab;
    __device__ __forceinline__ void ksetup(const Unit& u) const {
        PG8_LAS f32x4* T = (PG8_LAS f32x4*)(tab + ((u.pm >> 3) & 1) * 4096);
        const int tid = threadIdx.x;
        if (tid < 256) {
            const float* q = ssq + (size_t)(u.pm * BM + tid) * 8;
            const f32x4 q0 = *(const f32x4*)q, q1 = *(const f32x4*)(q + 4);
            const float ms0 = ((q0[0] + q0[1]) + (q0[2] + q0[3])) * (1.0f / 256.0f) + 1e-6f, ms1 = ((q1[0] + q1[1]) + (q1[2] + q1[3])) * (1.0f / 256.0f) + 1e-6f;
            const float r0 = __builtin_amdgcn_rsqf(ms0), r1 = __builtin_amdgcn_rsqf(ms1);
            T[tid] = (f32x4){ms0 * r0, ms1 * r1 * r0, r1, 0.f};
        }
    }
    __device__ __forceinline__ void kscale(f32x4 (&acc)[2][2][4][2], const Unit& u, int t, int wr, int fr) const {
        PG8_LAS f32x4* T = (PG8_LAS f32x4*)(tab + ((u.pm >> 3) & 1) * 4096);
        int rbase = wr * 64 + fr; asm volatile("" : "+v"(rbase));
#pragma unroll
        for (int ai = 0; ai < 2; ++ai)
#pragma unroll
            for (int m = 0; m < 4; ++m) {
                const f32x4 tv = T[rbase + ai * HALF + m * 16];
                const float f = (t == 8) ? tv[0] : tv[1];
#pragma unroll
                for (int bj = 0; bj < 2; ++bj)
#pragma unroll
                    for (int n = 0; n < 2; ++n) acc[ai][bj][m][n] = acc[ai][bj][m][n] * f;
            }
    }
    __device__ __forceinline__ void operator()(const f32x4 (&acc)[2][2][4][2], const Unit& u, int wr, int wc, int fr, int fq) const {
        const PG8_LAS f32x4* T = (const PG8_LAS f32x4*)(tab + ((u.pm >> 3) & 1) * 4096);
        const int rl0 = wr * 64 + fr, col0 = u.pn * BM + wc * 32 + 8 * fq;
#pragma unroll
        for (int ai = 0; ai < 2; ++ai)
#pragma unroll
            for (int m = 0; m < 4; ++m) { const int rl = rl0 + ai * HALF + m * 16; bf16_t* rowp = O + (size_t)(u.pm * BM + rl) * ldc + col0;
                const float f = T[rl][2];
#pragma unroll
                for (int bj = 0; bj < 2; ++bj) { const f32x4 v0 = acc[ai][bj][m][0] * f, v1 = acc[ai][bj][m][1] * f;
                    u32x4 w; w.x = cvt_pk_bf16(v0[0], v0[1]); w.y = cvt_pk_bf16(v0[2], v0[3]); w.z = cvt_pk_bf16(v1[0], v1[1]); w.w = cvt_pk_bf16(v1[2], v1[3]);
                    *(u32x4*)(rowp + bj * HALF) = w; } }
    }
};
template <class Epi, class Sched, bool ALIGN_EPI = false, bool SP2 = false>
__device__ __forceinline__ void gemm_phase(PG8_LAS unsigned char* lds, const Gemm g, const Sched& S, const Epi& E) {
    const int tid = threadIdx.x, wid = __builtin_amdgcn_readfirstlane(tid >> 6), lane = tid & 63, wr = wid >> 2, wc = wid & 3, fr = lane & 15, fq = lane >> 4;
    const int K = g.K, nt = K / BK;
    unsigned voffA[2], voffB[2];
#pragma unroll
    for (int i = 0; i < 2; ++i) { int R, C; stage_rc(tid * 16 + i * 8192, R, C); const int Rb = Epi::PERM ? ((R & ~31) + perm32(R & 31)) : R;
        voffA[i] = (unsigned)(R * K + C) * 2u; voffB[i] = (unsigned)(Rb * K + C) * 2u; }
    const size_t kstep = (size_t)(BK * 2);
    const size_t hstep = (size_t)HALF * K * 2;
    const size_t tstep = 2 * hstep;
    const unsigned ldsw = (unsigned)wid * 1024u;
    const int aoff = lds_byte(wr * 64 + fr, fq * 8), boff = lds_byte(wc * 32 + fr, fq * 8);
#define PG8_SA(b, h) (((b) * 2 + (h)) * HTB)
#define PG8_SB(b, h) ((4 + (b) * 2 + (h)) * HTB)
#define PG8_STAGE(bufoff, gbase, voff) do { _Pragma("unroll") for (int _i = 0; _i < 2; ++_i) \
        __builtin_amdgcn_global_load_lds((const unsigned*)((const char*)(gbase) + (voff)[_i]), (PG8_LAS unsigned*)(lds + (bufoff) + ldsw + _i * 8192), 16, 0, 0); } while (0)
#define PG8_LDA(dst, b, h) do { _Pragma("unroll") for (int m = 0; m < 4; ++m) _Pragma("unroll") for (int k = 0; k < 2; ++k) dst[m][k] = *(const PG8_LAS bf16x8*)(lds + PG8_SA(b, h) + aoff + m * 2048 + k * 1024); } while (0)
#define PG8_LDB(dst, b, h) do { _Pragma("unroll") for (int n = 0; n < 2; ++n) _Pragma("unroll") for (int k = 0; k < 2; ++k) dst[n][k] = *(const PG8_LAS bf16x8*)(lds + PG8_SB(b, h) + boff + n * 2048 + k * 1024); } while (0)
#define PG8_MMA(ai, bj, At, Bt) do { __builtin_amdgcn_s_setprio(1); _Pragma("unroll") for (int m = 0; m < 4; ++m) _Pragma("unroll") for (int n = 0; n < 2; ++n) _Pragma("unroll") for (int k = 0; k < 2; ++k) \
        acc[ai][bj][m][n] = __builtin_amdgcn_mfma_f32_16x16x32_bf16(Bt[n][k], At[m][k], acc[ai][bj][m][n], 0, 0, 0); __builtin_amdgcn_s_setprio(0); } while (0)
#define PG8_WAIT_V(n) asm volatile("s_waitcnt vmcnt(" #n ")" ::: "memory")
#define PG8_WAIT_L(n) asm volatile("s_waitcnt lgkmcnt(" #n ")" ::: "memory")
#define PG8_BAR __builtin_amdgcn_s_barrier()
#define PG8_SCHED __builtin_amdgcn_sched_barrier(0)
    Unit cur, nxt; int ui = 0;
    if (!S.next(0, cur)) return;
    if constexpr (Epi::KSCALE) E.ksetup(cur);
    f32x4 acc[2][2][4][2];
#pragma unroll
    for (int a = 0; a < 2; ++a)
#pragma unroll
        for (int b = 0; b < 2; ++b)
#pragma unroll
            for (int m = 0; m < 4; ++m)
#pragma unroll
                for (int n = 0; n < 2; ++n) acc[a][b][m][n] = (f32x4){0.f, 0.f, 0.f, 0.f};
    bf16x8 At[4][2], B0[2][2], B1[2][2];
    const char* cA = (const char*)g.A + (size_t)cur.pm * tstep; const char* cB = (const char*)g.Bt + (size_t)cur.pn * tstep;
    S.a_ready(cur);
    if constexpr (SP2) {
        PG8_STAGE(PG8_SB(0, 0), cB, voffB); PG8_STAGE(PG8_SB(0, 1), cB + hstep, voffB); PG8_STAGE(PG8_SA(0, 0), cA, voffA); PG8_STAGE(PG8_SA(0, 1), cA + hstep, voffA);
        if (wr == 1) PG8_BAR;
        PG8_WAIT_V(2); PG8_BAR;
        PG8_STAGE(PG8_SB(1, 0), cB + kstep, voffB); PG8_STAGE(PG8_SA(1, 0), cA + kstep, voffA); PG8_STAGE(PG8_SB(1, 1), cB + hstep + kstep, voffB);
        PG8_WAIT_V(6); PG8_BAR;
    } else {
        PG8_STAGE(PG8_SB(0, 0), cB, voffB); PG8_STAGE(PG8_SA(0, 0), cA, voffA); PG8_STAGE(PG8_SB(0, 1), cB + hstep, voffB); PG8_STAGE(PG8_SA(0, 1), cA + hstep, voffA);
        if (wr == 1) PG8_BAR;
        PG8_WAIT_V(4); PG8_BAR;
        PG8_STAGE(PG8_SB(1, 0), cB + kstep, voffB); PG8_STAGE(PG8_SA(1, 0), cA + kstep, voffA); PG8_STAGE(PG8_SB(1, 1), cB + hstep + kstep, voffB);
        PG8_WAIT_V(6); PG8_BAR;
    }
    for (;;) {
        const bool has_next = S.next(ui + 1, nxt);
        const char* nA = has_next ? (const char*)g.A + (size_t)nxt.pm * tstep : cA; const char* nB = has_next ? (const char*)g.Bt + (size_t)nxt.pn * tstep : cB;
        for (int t = 0; t < nt; t += 2) {
            if constexpr (Epi::KSCALE) { if (t == 8 || t == 12) E.kscale(acc, cur, t, wr, fr); }
            const bool last = (t == nt - 2);
            const char* a1 = cA + (size_t)(t + 1) * kstep;
            const char* a2 = last ? nA : cA + (size_t)(t + 2) * kstep; const char* b2 = last ? nB : cB + (size_t)(t + 2) * kstep;
            const char* a3 = a2 + kstep; const char* b3 = b2 + kstep;
            if (last && has_next) S.a_ready(nxt);
            if constexpr (SP2) {
            PG8_LDB(B0, 0, 0); PG8_LDB(B1, 0, 1); PG8_SCHED; PG8_LDA(At, 0, 0); PG8_STAGE(PG8_SA(1, 1), a1 + hstep, voffA);
            PG8_WAIT_V(8); PG8_WAIT_L(0); PG8_BAR; PG8_MMA(0, 0, At, B0); PG8_MMA(0, 1, At, B1); PG8_BAR; PG8_SCHED;
            PG8_LDA(At, 0, 1); PG8_STAGE(PG8_SB(0, 0), b2, voffB); PG8_STAGE(PG8_SB(0, 1), b2 + hstep, voffB); PG8_STAGE(PG8_SA(0, 0), a2, voffA);
            PG8_WAIT_V(8); PG8_WAIT_L(0); PG8_BAR; PG8_MMA(1, 0, At, B0); PG8_MMA(1, 1, At, B1); PG8_BAR; PG8_SCHED;
            PG8_LDB(B0, 1, 0); PG8_LDB(B1, 1, 1); PG8_SCHED; PG8_LDA(At, 1, 0); PG8_STAGE(PG8_SA(0, 1), a2 + hstep, voffA);
            PG8_WAIT_V(8); PG8_WAIT_L(0); PG8_BAR; PG8_MMA(0, 0, At, B0); PG8_MMA(0, 1, At, B1); PG8_BAR; PG8_SCHED;
            PG8_LDA(At, 1, 1); PG8_STAGE(PG8_SB(1, 0), b3, voffB); PG8_STAGE(PG8_SB(1, 1), b3 + hstep, voffB); PG8_STAGE(PG8_SA(1, 0), a3, voffA);
            PG8_WAIT_V(8); PG8_WAIT_L(0); PG8_BAR; PG8_MMA(1, 0, At, B0); PG8_MMA(1, 1, At, B1); PG8_BAR; PG8_SCHED;
            } else {
            PG8_LDB(B0, 0, 0); PG8_SCHED; PG8_LDA(At, 0, 0); PG8_STAGE(PG8_SA(1, 1), a1 + hstep, voffA);
            PG8_WAIT_L(8); PG8_BAR; PG8_WAIT_L(0); PG8_MMA(0, 0, At, B0); PG8_BAR; PG8_SCHED;
            PG8_LDB(B1, 0, 1); PG8_STAGE(PG8_SB(0, 0), b2, voffB);
            PG8_BAR; PG8_WAIT_L(0); PG8_MMA(0, 1, At, B1); PG8_BAR;
            PG8_LDA(At, 0, 1); PG8_STAGE(PG8_SA(0, 0), a2, voffA);
            PG8_BAR; PG8_WAIT_L(0); PG8_MMA(1, 0, At, B0); PG8_BAR; PG8_SCHED;
            PG8_STAGE(PG8_SB(0, 1), b2 + hstep, voffB);
            PG8_WAIT_V(6); PG8_BAR; PG8_MMA(1, 1, At, B1); PG8_BAR;
            PG8_LDB(B0, 1, 0); PG8_SCHED; PG8_LDA(At, 1, 0); PG8_STAGE(PG8_SA(0, 1), a2 + hstep, voffA);
            PG8_WAIT_L(8); PG8_BAR; PG8_WAIT_L(0); PG8_MMA(0, 0, At, B0); PG8_BAR; PG8_SCHED;
            PG8_LDB(B1, 1, 1); PG8_STAGE(PG8_SB(1, 0), b3, voffB);
            PG8_BAR; PG8_WAIT_L(0); PG8_MMA(0, 1, At, B1); PG8_BAR;
            PG8_LDA(At, 1, 1); PG8_STAGE(PG8_SA(1, 0), a3, voffA);
            PG8_BAR; PG8_WAIT_L(0); PG8_MMA(1, 0, At, B0); PG8_BAR; PG8_SCHED;
            PG8_STAGE(PG8_SB(1, 1), b3 + hstep, voffB);
            PG8_WAIT_V(6); PG8_BAR; PG8_MMA(1, 1, At, B1); PG8_BAR;
            }
        }
        if constexpr (ALIGN_EPI) { if (wr == 0) PG8_BAR; }
        if constexpr (!Epi::AFTER_DRAIN) { E(acc, cur, wr, wc, fr, fq); S.done(cur); }
        if (!has_next) break;
#pragma unroll
        for (int a = 0; a < 2; ++a)
#pragma unroll
            for (int b = 0; b < 2; ++b)
#pragma unroll
                for (int m = 0; m < 4; ++m)
#pragma unroll
                    for (int n = 0; n < 2; ++n) acc[a][b][m][n] = (f32x4){0.f, 0.f, 0.f, 0.f};
        cur = nxt; cA = nA; cB = nB; ++ui;
        if constexpr (Epi::KSCALE) E.ksetup(cur);
        if constexpr (ALIGN_EPI) { if (wr == 1) PG8_BAR; }
    }
    PG8_WAIT_V(0);
    if constexpr (!ALIGN_EPI) { if (wr == 0) PG8_BAR; }
    PG8_BAR;
    if constexpr (Epi::AFTER_DRAIN) { E.fused(acc, cur, wr, wc, fr, fq, lds, wid, lane); S.done(cur); }
#undef PG8_SA
#undef PG8_SB
#undef PG8_STAGE
#undef PG8_LDA
#undef PG8_LDB
#undef PG8_MMA
#undef PG8_WAIT_V
#undef PG8_WAIT_L
#undef PG8_BAR
#undef PG8_SCHED
}
}

#ifndef MK_N_LAUNCHES
#define MK_N_LAUNCHES 1
#endif
namespace cg = cooperative_groups;
#define LAS __attribute__((address_space(3)))
typedef unsigned short bf16;
typedef float f32x4 __attribute__((ext_vector_type(4)));
typedef float f32x2 __attribute__((ext_vector_type(2)));
typedef short bf16x8 __attribute__((ext_vector_type(8)));
typedef unsigned u32x4 __attribute__((ext_vector_type(4)));
typedef unsigned u32x2 __attribute__((ext_vector_type(2)));

constexpr int NWAVES = 8, NTHR = 512;
constexpr int NB = 16, SEQ = 2048, T = NB * SEQ, DM = 1024, NP = 2560, LDW_IN = 2568, FF = 4096;
constexpr int CHK = 128, NCH = SEQ / CHK;
constexpr int C_U = 0, C_V = 512, C_Z = 1024, C_X = 1536, C_B = 2048, C_C = 2304;
constexpr float EPS = 1e-6f;
constexpr size_t MiB = 1u << 20;
constexpr size_t WS_WIN = 2 * MiB, WS_WOUT = 8 * MiB, WS_WUP = 10 * MiB, WS_WDN = 18 * MiB, WS_WS = 26 * MiB, WS_DT = 27 * MiB, WS_SSQ = 28 * MiB;
constexpr size_t WS_H = 32 * MiB, WS_P = 96 * MiB, WS_MIX = 256 * MiB, WS_F = 96 * MiB, WS_O = 352 * MiB, WS_XBC = 352 * MiB  , WS_DN = 352 * MiB, WS_X1B = 416 * MiB, WS_END = 480 * MiB;
constexpr int LDS_BYTES = 149504, MISC_OFF = 148480;
constexpr size_t WS_CTL = 0, CTL_ZERO_BYTES = 16384;
constexpr int CW_TMO = 3584, CW_CNT = 4096, CNT_BANK = 128 * 64;

__device__ __forceinline__ unsigned cvt_pk(float lo, float hi) { unsigned r; asm volatile("v_cvt_pk_bf16_f32 %0, %1, %2" : "=v"(r) : "v"(lo), "v"(hi)); return r; }
__device__ __forceinline__ float bf_lo(unsigned w) { return __uint_as_float(w << 16); }
__device__ __forceinline__ float bf_hi(unsigned w) { return __uint_as_float(w & 0xffff0000u); }
__device__ __forceinline__ float wave_sum(float v) {
#pragma unroll
    for (int o = 1; o < 64; o <<= 1) v += __shfl_xor(v, o);
    return v;
}
__device__ __forceinline__ float gelu_tanh(float x) {
    const float y = 1.5957691216057308f * (x + 0.044715f * x * x * x);
    return x * __builtin_amdgcn_rcpf(1.0f + __expf(-y));
}
__device__ __forceinline__ float silu_f(float x) { return x * __builtin_amdgcn_rcpf(1.0f + __expf(-x)); }
#define LBAR() do { asm volatile("s_waitcnt lgkmcnt(0)" ::: "memory"); __builtin_amdgcn_s_barrier(); asm volatile("" ::: "memory"); } while (0)
__device__ __forceinline__ float softplus_f(float x) { return x > 20.f ? x : log1pf(__expf(x)); }

__device__ __forceinline__ void p0_transpose_item(const float* W, int K, int nblk, int ldw, bf16* WT, LAS float* scr, int item, int lane, const float* kscale = nullptr, int kscale_from = 0) {
    const int kb = item / nblk, nb = item % nblk, k0 = 64 * kb, n0 = 32 * nb;
    const float* ks = (kscale && k0 >= kscale_from) ? kscale + (k0 - kscale_from) : nullptr;
#pragma unroll
    for (int i = 0; i < 32; ++i) { const int kk = 2 * i + (lane >> 5); float val = __builtin_nontemporal_load(W + (size_t)(k0 + kk) * ldw + n0 + (lane & 31)); if (ks) val *= ks[kk]; scr[kk * 33 + (lane & 31)] = val; }
    asm volatile("s_waitcnt lgkmcnt(0)" ::: "memory");
    const int c = lane & 7;
#pragma unroll
    for (int j = 0; j < 4; ++j) { const int n = (lane >> 3) + 8 * j; const LAS float* s = scr + (8 * c) * 33 + n;
        u32x4 o; o.x = cvt_pk(s[0 * 33], s[1 * 33]); o.y = cvt_pk(s[2 * 33], s[3 * 33]); o.z = cvt_pk(s[4 * 33], s[5 * 33]); o.w = cvt_pk(s[6 * 33], s[7 * 33]);
        *(u32x4*)(WT + (size_t)(n0 + n) * K + k0 + 8 * c) = o; }
    asm volatile("s_waitcnt lgkmcnt(0)" ::: "memory");
}

#define XB_TMO      128
#define XB_XCNT(j)  (256  + 64 * (j))
#define XB_XSUB(j)  (1280 + 64 * (j))
#define XB_XGEN(j)  (2304 + 64 * (j))
#define XB_TOP      3328
#define XB_TOPGEN   3392
#define XCD_BAR_WORDS 3456
#define XB_SPIN_CAP (1u << 18)

__device__ __forceinline__ unsigned xb_ld(unsigned* p)              { return __hip_atomic_load(p, __ATOMIC_RELAXED, __HIP_MEMORY_SCOPE_AGENT); }
__device__ __forceinline__ unsigned xb_add(unsigned* p, unsigned v) { return __hip_atomic_fetch_add(p, v, __ATOMIC_RELAXED, __HIP_MEMORY_SCOPE_AGENT); }
__device__ __forceinline__ unsigned xb_xcc_id() { return (unsigned)__builtin_amdgcn_s_getreg((3 << 11) | 20) & 0xFu; }
#define XB_SPIN(cond, bar) do { unsigned _sp = 0; while (cond) { __builtin_amdgcn_s_sleep(1); \
    if ((++_sp & 255u) == 0u) { if (xb_ld(&(bar)[XB_TMO])) break; if (_sp > XB_SPIN_CAP) { atomicAdd(&(bar)[XB_TMO], 1u); break; } } } } while (0)

struct XcdBarrier {
    unsigned* bar; unsigned x;
    volatile LAS unsigned* st;
};

__device__ __forceinline__ XcdBarrier xcd_barrier_post(unsigned* bar, volatile LAS unsigned* st) {
    XcdBarrier b; b.bar = bar; b.x = xb_xcc_id(); b.st = st;
    if (threadIdx.x == 0) (void)xb_add(&bar[XB_XCNT(b.x)], 1u);
    return b;
}
__device__ __forceinline__ void xcd_barrier_complete(unsigned* bar, unsigned x, unsigned& nloc, unsigned& nx) {
    const unsigned G = gridDim.x * gridDim.y * gridDim.z;
    unsigned sum, cnt, mine, sp = 0u;
    for (;;) {
        sum = 0u; cnt = 0u; mine = 0u;
#pragma unroll
        for (unsigned j = 0; j < 16; ++j) { const unsigned c = xb_ld(&bar[XB_XCNT(j)]); sum += c; cnt += (c > 0u) ? 1u : 0u; mine = (j == x) ? c : mine; }
        if (sum == G) break;
        __builtin_amdgcn_s_sleep(1);
        if ((++sp & 255u) == 0u) { if (xb_ld(&bar[XB_TMO])) break; if (sp > XB_SPIN_CAP) { atomicAdd(&bar[XB_TMO], 1u); break; } }
    }
    nloc = mine > 0u ? mine : 1u; nx = cnt > 0u ? cnt : 1u;
}

__device__ __forceinline__ void xcd_barrier(const XcdBarrier& b) {
    asm volatile("s_waitcnt vmcnt(0)" ::: "memory");
    __syncthreads();
    if (threadIdx.x == 0) {
        unsigned* bar = b.bar;
        __builtin_amdgcn_s_waitcnt(0);
        unsigned nloc = b.st[0], nx = b.st[1];
        if (nloc == 0u) { xcd_barrier_complete(bar, b.x, nloc, nx); b.st[0] = nloc; b.st[1] = nx; }
        const unsigned old = xb_add(&bar[XB_XSUB(b.x)], 1u);
        const unsigned gen = old / nloc;
        if (old + 1u == (gen + 1u) * nloc) {
            __builtin_amdgcn_fence(__ATOMIC_RELEASE, "agent");
            asm volatile("s_waitcnt vmcnt(0)" ::: "memory");
            const unsigned og = xb_add(&bar[XB_TOP], 1u);
            const unsigned tg = og / nx;
            if (og + 1u == (tg + 1u) * nx) xb_add(&bar[XB_TOPGEN], 1u);
            else XB_SPIN(xb_ld(&bar[XB_TOPGEN]) == tg, bar);
            __builtin_amdgcn_fence(__ATOMIC_ACQUIRE, "agent");
            xb_add(&bar[XB_XGEN(b.x)], 1u);
            asm volatile("s_waitcnt vmcnt(0)" ::: "memory");
        } else {
            XB_SPIN(xb_ld(&bar[XB_XGEN(b.x)]) == gen, bar);
            __builtin_amdgcn_fence(__ATOMIC_ACQUIRE, "agent");
            asm volatile("s_waitcnt vmcnt(0)" ::: "memory");
        }
    }
    __syncthreads();
}

struct Args {
    const float *x, *norm_mix_pre, *w_in, *gm_ln_w, *gm_ln_b, *gm_w_s, *gm_b_s, *conv_w, *conv_b, *dt_bias, *a_log, *d_skip, *ssm_norm_w, *w_out, *norm_mix_post, *norm_ffn_pre, *w_up, *w_down, *norm_ffn_post;
    float* out; unsigned char* ws; int ph_lo, ph_hi;
};

__device__ __forceinline__ void phase_prologue(const Args& a, LAS unsigned char* lds, int tid, int lane, int wave, int G) {
    unsigned char* ws = a.ws;
    bf16* Win_t = (bf16*)(ws + WS_WIN); bf16* Wout_t = (bf16*)(ws + WS_WOUT); bf16* Wup_t = (bf16*)(ws + WS_WUP); bf16* Wdn_t = (bf16*)(ws + WS_WDN);
    bf16* Wsb = (bf16*)(ws + WS_WS); float* DT = (float*)(ws + WS_DT); bf16* H = (bf16*)(ws + WS_H);
    const int gw = blockIdx.x * NWAVES + wave, NGW = G * NWAVES;
    {
        LAS float* scr = (LAS float*)(lds + wave * 16384);
        constexpr int I_IN = (DM / 64) * (NP / 32);
        for (int it = gw; it < I_IN; it += NGW) p0_transpose_item(a.w_in, DM, NP / 32, LDW_IN, Win_t, scr, it, lane);
    }
    for (int i = blockIdx.x * NTHR + tid; i < 8 * 128 * 128 / 4; i += G * NTHR) {
        const int e = i * 4, s0 = e & 127, t = (e >> 7) & 127;
        const f32x4 w = *(const f32x4*)(a.gm_w_s + e);
        u32x2 o; o.x = cvt_pk(s0 + 0 <= t ? w.x : 0.f, s0 + 1 <= t ? w.y : 0.f); o.y = cvt_pk(s0 + 2 <= t ? w.z : 0.f, s0 + 3 <= t ? w.w : 0.f);
        *(u32x2*)(Wsb + e) = o;
    }
    f32x4 wn[4], wd[4][4][2];
#pragma unroll
    for (int j = 0; j < 4; ++j) {
        wn[j] = *(const f32x4*)(a.norm_mix_pre + 256 * j + 4 * lane);
#pragma unroll
        for (int e = 0; e < 4; ++e) { const float* wp = a.w_in + (size_t)(256 * j + 4 * lane + e) * LDW_IN + NP; wd[j][e][0] = *(const f32x4*)wp; wd[j][e][1] = *(const f32x4*)(wp + 4); }
    }
    const int hsel = (lane & 1) * 4 + (lane & 2) + ((lane >> 2) & 1);
    const float dtb = a.dt_bias[hsel];
    const bool b0 = lane & 1, b1 = lane & 2, b2 = lane & 4;
    f32x4 v[4], vn[4], vnn[4];
#pragma unroll
    for (int j = 0; j < 4; ++j) { vn[j] = (f32x4){0.f, 0.f, 0.f, 0.f}; vnn[j] = vn[j]; }
    if (gw < T) {
        const f32x4* xr = (const f32x4*)(a.x + (size_t)gw * DM) + lane;
#pragma unroll
        for (int j = 0; j < 4; ++j) vn[j] = __builtin_nontemporal_load(xr + 64 * j);
    }
    if (gw + NGW < T) {
        const f32x4* xr = (const f32x4*)(a.x + (size_t)(gw + NGW) * DM) + lane;
#pragma unroll
        for (int j = 0; j < 4; ++j) vnn[j] = __builtin_nontemporal_load(xr + 64 * j);
    }
    for (int m = gw; m < T; m += NGW) {
#pragma unroll
        for (int j = 0; j < 4; ++j) { v[j] = vn[j]; vn[j] = vnn[j]; }
        if (m + 2 * NGW < T) {
            const f32x4* xr = (const f32x4*)(a.x + (size_t)(m + 2 * NGW) * DM) + lane;
#pragma unroll
            for (int j = 0; j < 4; ++j) vnn[j] = __builtin_nontemporal_load(xr + 64 * j);
        }
        float s = 0.f;
#pragma unroll
        for (int j = 0; j < 4; ++j) s += (v[j].x * v[j].x + v[j].y * v[j].y) + (v[j].z * v[j].z + v[j].w * v[j].w);
        const float r = __builtin_amdgcn_rsqf(wave_sum(s) * (1.f / DM) + EPS);
        f32x4 a0 = (f32x4){0.f, 0.f, 0.f, 0.f}, a1 = a0;
        unsigned long long* o8 = (unsigned long long*)(H + (size_t)m * DM) + lane;
#pragma unroll
        for (int j = 0; j < 4; ++j) {
            v[j] = v[j] * r * wn[j];
            o8[64 * j] = (unsigned long long)cvt_pk(v[j].x, v[j].y) | ((unsigned long long)cvt_pk(v[j].z, v[j].w) << 32);
#pragma unroll
            for (int e = 0; e < 4; ++e) { a0 += wd[j][e][0] * v[j][e]; a1 += wd[j][e][1] * v[j][e]; }
        }
        float c0, c1, c2, c3;
        { const f32x4 snd = b0 ? a0 : a1, kp = b0 ? a1 : a0;
          c0 = kp.x + __shfl_xor(snd.x, 1); c1 = kp.y + __shfl_xor(snd.y, 1); c2 = kp.z + __shfl_xor(snd.z, 1); c3 = kp.w + __shfl_xor(snd.w, 1); }
        float d0, d1;
        { const float s0 = b1 ? c0 : c2, s1 = b1 ? c1 : c3, k0 = b1 ? c2 : c0, k1 = b1 ? c3 : c1;
          d0 = k0 + __shfl_xor(s0, 2); d1 = k1 + __shfl_xor(s1, 2); }
        float e0;
        { const float s0 = b2 ? d0 : d1, k0 = b2 ? d1 : d0; e0 = k0 + __shfl_xor(s0, 4); }
        e0 += __shfl_xor(e0, 8); e0 += __shfl_xor(e0, 16); e0 += __shfl_xor(e0, 32);
        if (lane < 8) DT[(size_t)m * 8 + hsel] = softplus_f(e0 + dtb);
    }
}

constexpr int RS = 272;
constexpr int L_CL = 0, L_BS = 34816, L_BT = 69632, L_XT = 104448, L_SB = 121856, L_SM = 139264;
#define MFMA16(a, b, c) __builtin_amdgcn_mfma_f32_16x16x32_bf16((a), (b), (c), 0, 0, 0)
#define FRAG(base, row, kel) (*(const LAS bf16x8*)((base) + (row) * RS + (kel) * 2))

__device__ __forceinline__ void phase_conv(const Args& a, int tid, int G) {
    const bf16* P = (const bf16*)(a.ws + WS_P); bf16* XBC = (bf16*)(a.ws + WS_XBC);
    constexpr int NTASK = (T / 8) * 128;
    for (int task = blockIdx.x * NTHR + tid; task < NTASK; task += G * NTHR) {
        const int cg8 = task & 127, rb = task >> 7, chan = cg8 * 8, row0 = rb * 8, tl0 = row0 & (SEQ - 1);
        float cw[4][8], cb[8];
#pragma unroll
        for (int k = 0; k < 4; ++k) { const f32x4 w0 = *(const f32x4*)(a.conv_w + k * 1024 + chan), w1 = *(const f32x4*)(a.conv_w + k * 1024 + chan + 4);
            cw[k][0] = w0.x; cw[k][1] = w0.y; cw[k][2] = w0.z; cw[k][3] = w0.w; cw[k][4] = w1.x; cw[k][5] = w1.y; cw[k][6] = w1.z; cw[k][7] = w1.w; }
        { const f32x4 b0 = *(const f32x4*)(a.conv_b + chan), b1 = *(const f32x4*)(a.conv_b + chan + 4);
            cb[0] = b0.x; cb[1] = b0.y; cb[2] = b0.z; cb[3] = b0.w; cb[4] = b1.x; cb[5] = b1.y; cb[6] = b1.z; cb[7] = b1.w; }
        u32x4 raw[11];
#pragma unroll
        for (int i = 0; i < 11; ++i) raw[i] = (tl0 - 3 + i >= 0) ? __builtin_nontemporal_load((const u32x4*)(P + (size_t)(row0 - 3 + i) * NP + C_X + chan)) : (u32x4){0u, 0u, 0u, 0u};
#pragma unroll
        for (int r = 0; r < 8; ++r) {
            float v[8];
#pragma unroll
            for (int e = 0; e < 8; ++e) {
                float s = cb[e];
#pragma unroll
                for (int k = 0; k < 4; ++k) { const unsigned wd = raw[r + k][e >> 1]; s += cw[k][e] * ((e & 1) ? bf_hi(wd) : bf_lo(wd)); }
                v[e] = silu_f(s);
            }
            u32x4 o; o.x = cvt_pk(v[0], v[1]); o.y = cvt_pk(v[2], v[3]); o.z = cvt_pk(v[4], v[5]); o.w = cvt_pk(v[6], v[7]);
            *(u32x4*)(XBC + (size_t)(row0 + r) * 1024 + chan) = o;
        }
    }
}

typedef short s16x4 __attribute__((ext_vector_type(4)));
__device__ __forceinline__ bf16x8 tr_frag(const LAS unsigned char* lanebase, int offA, int offB) {
    const s16x4 x = __builtin_amdgcn_ds_read_tr16_b64_v4i16((LAS s16x4*)(lanebase + offA));
    const s16x4 y = __builtin_amdgcn_ds_read_tr16_b64_v4i16((LAS s16x4*)(lanebase + offB));
    return (bf16x8){x[0], x[1], x[2], x[3], y[0], y[1], y[2], y[3]};
}
constexpr int XS_RS = 144;

__device__ __forceinline__ void gmlp_items(const Args& a, LAS unsigned char* lds, int first, int step, int tid, int lane, int wave) {
    const bf16* P = (const bf16*)(a.ws + WS_P); bf16* MIX = (bf16*)(a.ws + WS_MIX); const bf16* Wsb = (const bf16*)(a.ws + WS_WS);
    constexpr int NITEM = NB * NCH * 8;
    LAS unsigned char* VS = lds;
    const int s = tid >> 2, q = tid & 3;
    const int fr = lane & 15, fq = lane >> 4, w = wave;
    const int h = first & 7, tl = 16 * w + fr;
    const LAS unsigned char* vtr = VS + (8 * fq + ((lane & 15) >> 2)) * XS_RS + 8 * (lane & 3);
    float lw[16], lb[16];
#pragma unroll
    for (int i = 0; i < 4; ++i) { const f32x4 w4 = *(const f32x4*)(a.gm_ln_w + h * 64 + q * 16 + 4 * i), b4 = *(const f32x4*)(a.gm_ln_b + h * 64 + q * 16 + 4 * i);
        lw[4 * i] = w4.x; lw[4 * i + 1] = w4.y; lw[4 * i + 2] = w4.z; lw[4 * i + 3] = w4.w; lb[4 * i] = b4.x; lb[4 * i + 1] = b4.y; lb[4 * i + 2] = b4.z; lb[4 * i + 3] = b4.w; }
    bf16x8 af[4];
    const bf16* wrow = Wsb + ((size_t)h * 128 + 16 * w + fr) * 128 + fq * 8;
#pragma unroll
    for (int kk = 0; kk < 4; ++kk) af[kk] = (kk <= (w >> 1)) ? *(const bf16x8*)(wrow + kk * 32) : (bf16x8){0, 0, 0, 0, 0, 0, 0, 0};
    const float bs = a.gm_b_s[h * 128 + tl];
    u32x4 r0 = (u32x4){0u, 0u, 0u, 0u}, r1 = r0;
    if (first < NITEM) { const u32x4* src = (const u32x4*)(P + ((size_t)(first >> 3) * CHK + s) * NP + C_V + h * 64 + q * 16); r0 = __builtin_nontemporal_load(src); r1 = __builtin_nontemporal_load(src + 1); }
    __builtin_amdgcn_s_waitcnt(0);
    for (int item = first; item < NITEM; item += step) {
        const size_t t0 = (size_t)(item >> 3) * CHK; const size_t t = t0 + tl;
        u32x2 uu[4];
#pragma unroll
        for (int nt = 0; nt < 4; ++nt) uu[nt] = __builtin_nontemporal_load((const u32x2*)(P + t * NP + C_U + h * 64 + 16 * nt + fq * 4));
        float v[16];
        v[0] = bf_lo(r0.x); v[1] = bf_hi(r0.x); v[2] = bf_lo(r0.y); v[3] = bf_hi(r0.y); v[4] = bf_lo(r0.z); v[5] = bf_hi(r0.z); v[6] = bf_lo(r0.w); v[7] = bf_hi(r0.w);
        v[8] = bf_lo(r1.x); v[9] = bf_hi(r1.x); v[10] = bf_lo(r1.y); v[11] = bf_hi(r1.y); v[12] = bf_lo(r1.z); v[13] = bf_hi(r1.z); v[14] = bf_lo(r1.w); v[15] = bf_hi(r1.w);
        float sm = 0.f;
#pragma unroll
        for (int i = 0; i < 16; ++i) { v[i] = gelu_tanh(v[i]); sm += v[i]; }
        sm += __shfl_xor(sm, 1); sm += __shfl_xor(sm, 2);
        const float mu = sm * (1.f / 64.f); float sq = 0.f;
#pragma unroll
        for (int i = 0; i < 16; ++i) { v[i] -= mu; sq += v[i] * v[i]; }
        sq += __shfl_xor(sq, 1); sq += __shfl_xor(sq, 2);
        const float rstd = __builtin_amdgcn_rsqf(sq * (1.f / 64.f) + EPS);
#pragma unroll
        for (int i = 0; i < 16; ++i) v[i] = v[i] * rstd * lw[i] + lb[i];
        LBAR();
        { u32x4 o0, o1; o0.x = cvt_pk(v[0], v[1]); o0.y = cvt_pk(v[2], v[3]); o0.z = cvt_pk(v[4], v[5]); o0.w = cvt_pk(v[6], v[7]);
          o1.x = cvt_pk(v[8], v[9]); o1.y = cvt_pk(v[10], v[11]); o1.z = cvt_pk(v[12], v[13]); o1.w = cvt_pk(v[14], v[15]);
          LAS u32x4* dst = (LAS u32x4*)(VS + s * XS_RS + q * 32); dst[0] = o0; dst[1] = o1; }
        { const int nx = item + step; if (nx < NITEM) { const u32x4* src = (const u32x4*)(P + ((size_t)(nx >> 3) * CHK + s) * NP + C_V + h * 64 + q * 16); r0 = __builtin_nontemporal_load(src); r1 = __builtin_nontemporal_load(src + 1); } }
        LBAR();
        f32x4 acc[4];
#pragma unroll
        for (int nt = 0; nt < 4; ++nt) acc[nt] = (f32x4){0.f, 0.f, 0.f, 0.f};
#pragma unroll
        for (int kk = 0; kk < 4; ++kk) {
            if (kk <= (w >> 1)) {
                bf16x8 vfr[4];
#pragma unroll
                for (int nt = 0; nt < 4; ++nt) vfr[nt] = tr_frag(vtr, (32 * kk) * XS_RS + 32 * nt, (32 * kk + 4) * XS_RS + 32 * nt);
                __builtin_amdgcn_sched_barrier(0);
#pragma unroll
                for (int nt = 0; nt < 4; ++nt) acc[nt] = MFMA16(vfr[nt], af[kk], acc[nt]);
                __builtin_amdgcn_sched_barrier(0);
            }
        }
#pragma unroll
        for (int nt = 0; nt < 4; ++nt) {
            const int col = h * 64 + 16 * nt + fq * 4;
            const float o0 = gelu_tanh(bf_lo(uu[nt].x)) * (acc[nt][0] + bs), o1 = gelu_tanh(bf_hi(uu[nt].x)) * (acc[nt][1] + bs);
            const float o2 = gelu_tanh(bf_lo(uu[nt].y)) * (acc[nt][2] + bs), o3 = gelu_tanh(bf_hi(uu[nt].y)) * (acc[nt][3] + bs);
            u32x2 o; o.x = cvt_pk(o0, o1); o.y = cvt_pk(o2, o3);
            *(u32x2*)(MIX + t * DM + col) = o;
        }
    }
}

template <int W>
__device__ __forceinline__ void ssd_cb_ydiag(u32x2 (&gq)[8], f32x4 (&accY)[4], const bf16x8 (&cf)[4], const LAS unsigned char* BS, const LAS unsigned char* xtr_prm,
                                             const LAS float* acs, const LAS float* esd, const LAS float* dtv, float acl, int l, int fr, int fq) {
    constexpr int NO = W > 0 ? W : 1;
    f32x4 cbv[W + 1];
#pragma unroll
    for (int j = 0; j <= W; ++j) cbv[j] = (f32x4){0.f, 0.f, 0.f, 0.f};
#pragma unroll
    for (int kk = 0; kk < 4; ++kk)
    {
        bf16x8 bfr[W + 1];
#pragma unroll
        for (int j = 0; j <= W; ++j) bfr[j] = FRAG(BS, 16 * j + fr, kk * 32 + fq * 8);
        __builtin_amdgcn_sched_barrier(0);
#pragma unroll
        for (int j = 0; j <= W; ++j) cbv[j] = MFMA16(bfr[j], cf[kk], cbv[j]);
        __builtin_amdgcn_sched_barrier(0);
    }
    float refv[NO]; f32x4 e4[NO];
#pragma unroll
    for (int j = 0; j < W; ++j) { refv[j] = acs[16 * j + 15]; e4[j] = *(const LAS f32x4*)(esd + 16 * j + fq * 4); }
    const f32x4 as4 = *(const LAS f32x4*)(acs + 16 * W + fq * 4), dt4 = *(const LAS f32x4*)(dtv + 16 * W + fq * 4);
    __builtin_amdgcn_sched_barrier(0);
    constexpr int NK = W / 2 + 1;
#pragma unroll
    for (int j = 0; j < 8; ++j) gq[j] = (u32x2){0u, 0u};
#pragma unroll
    for (int j = 0; j < W; ++j) {
        const float el = __expf(acl - refv[j]);
        const f32x4 gv = cbv[j] * el * e4[j];
        gq[j].x = cvt_pk(gv[0], gv[1]); gq[j].y = cvt_pk(gv[2], gv[3]);
    }
    {
        const int s0 = 16 * W + fq * 4; float gv[4];
#pragma unroll
        for (int r = 0; r < 4; ++r) { const float dec = __expf(fminf(acl - as4[r], 0.f)); gv[r] = (s0 + r <= l) ? cbv[W][r] * dec * dt4[r] : 0.f; }
        gq[W].x = cvt_pk(gv[0], gv[1]); gq[W].y = cvt_pk(gv[2], gv[3]);
    }
#pragma unroll
    for (int kk = 0; kk < NK; ++kk) {
        union { u32x4 u; bf16x8 v; } gf; gf.u = (u32x4){gq[2 * kk].x, gq[2 * kk].y, gq[2 * kk + 1].x, gq[2 * kk + 1].y};
        {
            bf16x8 xfr[4];
#pragma unroll
            for (int nt = 0; nt < 4; ++nt) xfr[nt] = tr_frag(xtr_prm, (32 * kk) * XS_RS + 32 * nt, (32 * kk + 16) * XS_RS + 32 * nt);
            __builtin_amdgcn_sched_barrier(0);
#pragma unroll
            for (int nt = 0; nt < 4; ++nt) accY[nt] = MFMA16(xfr[nt], gf.v, accY[nt]);
            __builtin_amdgcn_sched_barrier(0);
        }
    }
}

constexpr int L2_CL = 0, L2_BS = 34816, L2_XS = 69632, L2_SB = 88064, L2_SM = 105472;
__device__ __forceinline__ void ssd_item(const Args& a, LAS unsigned char* lds, int item, int tid, int lane, int wave) {
    const bf16* P = (const bf16*)(a.ws + WS_P); const bf16* XBC = (const bf16*)(a.ws + WS_XBC); bf16* MIX = (bf16*)(a.ws + WS_MIX);
    const float* DT = (const float*)(a.ws + WS_DT); float* SSQ = (float*)(a.ws + WS_SSQ);
    const int h = item & 7, b = item >> 3, g = h >> 2;
    const int fr = lane & 15, fq = lane >> 4, w = wave;
    LAS unsigned char* CL = lds + L2_CL; LAS unsigned char* BS = lds + L2_BS; LAS unsigned char* XS = lds + L2_XS; LAS unsigned char* SB = lds + L2_SB;
    LAS float* tabs = (LAS float*)(lds + L2_SM);
    const float A = -__expf(a.a_log[h]); const float dsk = a.d_skip[h];
    f32x4 accS[4];
#pragma unroll
    for (int i = 0; i < 4; ++i) accS[i] = (f32x4){0.f, 0.f, 0.f, 0.f};
    const int pt = w >> 1, nb0 = (w & 1) * 4;
    const int trq = (lane & 15) >> 2, trp = lane & 3;
    const LAS unsigned char* xtr_std = XS + (8 * fq + trq) * XS_RS + 8 * trp;
    const LAS unsigned char* xtr_prm = XS + (4 * fq + trq) * XS_RS + 8 * trp;
    const LAS unsigned char* btr_std = BS + (8 * fq + trq) * RS + 8 * trp;
    u32x4 rc[4], rb_[4], rx[2];
#define SSD_LOADS(cc) do { const size_t tb_ = (size_t)b * SEQ + (size_t)(cc) * CHK; \
        _Pragma("unroll") for (int i_ = 0; i_ < 4; ++i_) { const int idx_ = tid + 512 * i_; const bf16* rp_ = XBC + (tb_ + (idx_ >> 4)) * 1024 + g * 128 + (idx_ & 15) * 8; rb_[i_] = *(const u32x4*)(rp_ + 512); } \
        _Pragma("unroll") for (int k_ = 0; k_ < 4; ++k_) rc[k_] = *(const u32x4*)(XBC + (tb_ + 16 * w + fr) * 1024 + 768 + g * 128 + k_ * 32 + fq * 8); \
        _Pragma("unroll") for (int i_ = 0; i_ < 2; ++i_) { const int idx_ = tid + 512 * i_; rx[i_] = __builtin_nontemporal_load((const u32x4*)(XBC + (tb_ + (idx_ >> 3)) * 1024 + h * 64 + (idx_ & 7) * 8)); } \
        } while (0)
    SSD_LOADS(0);
    {
        float dd[2][2];
#pragma unroll
        for (int k = 0; k < 2; ++k) { const size_t tb = (size_t)b * SEQ + (size_t)(2 * w + k) * CHK; dd[k][0] = DT[(tb + lane) * 8 + h]; dd[k][1] = DT[(tb + 64 + lane) * 8 + h]; }
#pragma unroll
        for (int k = 0; k < 2; ++k) {
            LAS float* acs = tabs + (2 * w + k) * 640; LAS float* esd = acs + 128; LAS float* wgt = acs + 256; LAS float* eacs = acs + 384; LAS float* dtv = acs + 512;
            const float d0 = dd[k][0], d1 = dd[k][1];
            float s0 = d0 * A, s1 = d1 * A;
#pragma unroll
            for (int o = 1; o < 64; o <<= 1) { const float u0 = __shfl_up(s0, o), u1 = __shfl_up(s1, o); if (lane >= o) { s0 += u0; s1 += u1; } }
            s1 += __shfl(s0, 63);
            const float aend = __shfl(s1, 63);
            const float rf0 = __shfl(s0, lane | 15), rf1 = __shfl(s1, lane | 15);
            acs[lane] = s0; acs[64 + lane] = s1; dtv[lane] = d0; dtv[64 + lane] = d1;
            esd[lane] = d0 * __expf(rf0 - s0); esd[64 + lane] = d1 * __expf(rf1 - s1);
            wgt[lane] = d0 * __expf(aend - s0); wgt[64 + lane] = d1 * __expf(aend - s1);
            eacs[lane] = __expf(s0); eacs[64 + lane] = __expf(s1);
        }
    }
    __builtin_amdgcn_s_waitcnt(0);
    for (int c = 0; c < NCH; ++c) {
        const size_t t0 = (size_t)b * SEQ + (size_t)c * CHK;
        LBAR();
#pragma unroll
        for (int i = 0; i < 4; ++i) { u32x2 o; o.x = cvt_pk(accS[i][0], accS[i][1]); o.y = cvt_pk(accS[i][2], accS[i][3]);
            *(LAS u32x2*)(SB + (16 * pt + fr) * RS + (16 * (nb0 + i) + fq * 4) * 2) = o; }
        const LAS float* acs = tabs + c * 640; const LAS float* esd = acs + 128; const LAS float* wgt = acs + 256; const LAS float* eacs = acs + 384; const LAS float* dtv = acs + 512;
#pragma unroll
        for (int i = 0; i < 4; ++i) { const int idx = tid + 512 * i; *(LAS u32x4*)(BS + (idx >> 4) * RS + (idx & 15) * 16) = rb_[i]; }
#pragma unroll
        for (int i = 0; i < 2; ++i) { const int idx = tid + 512 * i; *(LAS u32x4*)(XS + (idx >> 3) * XS_RS + (idx & 7) * 16) = rx[i]; }
        bf16x8 cf[4];
#pragma unroll
        for (int kk = 0; kk < 4; ++kk) { union { u32x4 u; bf16x8 v; } cv; cv.u = rc[kk]; cf[kk] = cv.v; }
        if (c + 1 < NCH) SSD_LOADS(c + 1);
        LBAR();
        const int l = 16 * w + fr; const size_t t = t0 + l;
        u32x2 zz[4];
#pragma unroll
        for (int nt = 0; nt < 4; ++nt) zz[nt] = __builtin_nontemporal_load((const u32x2*)(P + t * NP + C_Z + h * 64 + 16 * nt + fq * 4));
        const float acl = acs[l];
        u32x2 gq[8];
        f32x4 accY[4];
#pragma unroll
        for (int nt = 0; nt < 4; ++nt) accY[nt] = (f32x4){0.f, 0.f, 0.f, 0.f};
        switch (w) {
            case 0: ssd_cb_ydiag<0>(gq, accY, cf, BS, xtr_prm, acs, esd, dtv, acl, l, fr, fq); break;
            case 1: ssd_cb_ydiag<1>(gq, accY, cf, BS, xtr_prm, acs, esd, dtv, acl, l, fr, fq); break;
            case 2: ssd_cb_ydiag<2>(gq, accY, cf, BS, xtr_prm, acs, esd, dtv, acl, l, fr, fq); break;
            case 3: ssd_cb_ydiag<3>(gq, accY, cf, BS, xtr_prm, acs, esd, dtv, acl, l, fr, fq); break;
            case 4: ssd_cb_ydiag<4>(gq, accY, cf, BS, xtr_prm, acs, esd, dtv, acl, l, fr, fq); break;
            case 5: ssd_cb_ydiag<5>(gq, accY, cf, BS, xtr_prm, acs, esd, dtv, acl, l, fr, fq); break;
            case 6: ssd_cb_ydiag<6>(gq, accY, cf, BS, xtr_prm, acs, esd, dtv, acl, l, fr, fq); break;
            default: ssd_cb_ydiag<7>(gq, accY, cf, BS, xtr_prm, acs, esd, dtv, acl, l, fr, fq); break;
        }
        f32x4 accO[4];
#pragma unroll
        for (int nt = 0; nt < 4; ++nt) accO[nt] = (f32x4){0.f, 0.f, 0.f, 0.f};
        if (c > 0) {
#pragma unroll
            for (int kk = 0; kk < 4; kk += 2) {
                bf16x8 sfr[2][4];
#pragma unroll
                for (int k2 = 0; k2 < 2; ++k2)
#pragma unroll
                    for (int nt = 0; nt < 4; ++nt) sfr[k2][nt] = FRAG(SB, 16 * nt + fr, (kk + k2) * 32 + fq * 8);
                __builtin_amdgcn_sched_barrier(0);
#pragma unroll
                for (int k2 = 0; k2 < 2; ++k2)
#pragma unroll
                    for (int nt = 0; nt < 4; ++nt) accO[nt] = MFMA16(sfr[k2][nt], cf[kk + k2], accO[nt]);
                __builtin_amdgcn_sched_barrier(0);
            }
        }
        {
            const float ea = eacs[l]; float ssq = 0.f;
#pragma unroll
            for (int nt = 0; nt < 4; ++nt) {
                const int p0 = 16 * nt + fq * 4;
                const u32x2 xx = *(const LAS u32x2*)(XS + l * XS_RS + p0 * 2);
                const float xv[4] = {bf_lo(xx.x), bf_hi(xx.x), bf_lo(xx.y), bf_hi(xx.y)};
                const float zv[4] = {bf_lo(zz[nt].x), bf_hi(zz[nt].x), bf_lo(zz[nt].y), bf_hi(zz[nt].y)};
                float yo[4];
#pragma unroll
                for (int r = 0; r < 4; ++r) {
                    float y = accY[nt][r] + ea * accO[nt][r] + dsk * xv[r];
                    y *= silu_f(zv[r]); ssq += y * y; yo[r] = y;
                }
                u32x2 o; o.x = cvt_pk(yo[0], yo[1]); o.y = cvt_pk(yo[2], yo[3]);
                *(u32x2*)(MIX + t * DM + 512 + h * 64 + p0) = o;
            }
            ssq += __shfl_xor(ssq, 16); ssq += __shfl_xor(ssq, 32);
            if (fq == 0) SSQ[t * 8 + h] = ssq;
        }
        if (c + 1 < NCH) {
            const float cd = eacs[127];
#pragma unroll
            for (int i = 0; i < 4; ++i) accS[i] = accS[i] * cd;
#pragma unroll
            for (int kk = 0; kk < 4; ++kk) {
                bf16x8 bfr[4];
#pragma unroll
                for (int i = 0; i < 4; ++i) bfr[i] = tr_frag(btr_std + 32 * nb0, (32 * kk) * RS + 32 * i, (32 * kk + 4) * RS + 32 * i);
                union { u32x4 u; bf16x8 v; } xf; xf.v = tr_frag(xtr_std + 32 * pt, (32 * kk) * XS_RS, (32 * kk + 4) * XS_RS);
                const f32x4 w0 = *(const LAS f32x4*)(wgt + kk * 32 + fq * 8), w1 = *(const LAS f32x4*)(wgt + kk * 32 + fq * 8 + 4);
                xf.u.x = cvt_pk(bf_lo(xf.u.x) * w0.x, bf_hi(xf.u.x) * w0.y); xf.u.y = cvt_pk(bf_lo(xf.u.y) * w0.z, bf_hi(xf.u.y) * w0.w);
                xf.u.z = cvt_pk(bf_lo(xf.u.z) * w1.x, bf_hi(xf.u.z) * w1.y); xf.u.w = cvt_pk(bf_lo(xf.u.w) * w1.z, bf_hi(xf.u.w) * w1.w);
#pragma unroll
                for (int i = 0; i < 4; ++i) accS[i] = MFMA16(bfr[i], xf.v, accS[i]);
                __builtin_amdgcn_sched_barrier(0);
            }
        }
    }
#undef SSD_LOADS
}

__device__ __forceinline__ void convert_late_weights(const Args& a, LAS unsigned char* lds, int first_wave, int nwaves, int lane, int wave) {
    bf16* Wout_t = (bf16*)(a.ws + WS_WOUT); bf16* Wup_t = (bf16*)(a.ws + WS_WUP); bf16* Wdn_t = (bf16*)(a.ws + WS_WDN);
    LAS float* scr = (LAS float*)(lds + wave * 16384);
    constexpr int I_OUT = (DM / 64) * (DM / 32), I_UP = (DM / 64) * (FF / 32), I_DN = (FF / 64) * (DM / 32);
    for (int it = first_wave; it < I_OUT + I_UP + I_DN; it += nwaves) {
        int r = it;
        if (r < I_OUT) { p0_transpose_item(a.w_out, DM, DM / 32, DM, Wout_t, scr, r, lane, a.ssm_norm_w, 512); continue; } r -= I_OUT;
        if (r < I_UP) { p0_transpose_item(a.w_up, DM, FF / 32, FF, Wup_t, scr, r, lane); continue; } r -= I_UP;
        p0_transpose_item(a.w_down, FF, DM / 32, DM, Wdn_t, scr, r, lane);
    }
}

__device__ __forceinline__ void phase_mixer(const Args& a, LAS unsigned char* lds, int tid, int lane, int wave, int G) {
    const int half = G / 2, bx = blockIdx.x;
    if (bx < half) {
        for (int it = bx; it < NB * 8; it += half) {
            int item = it;
            if (half == 128) { const int x = it & 7, k = it >> 3, pair = x * 4 + (k >> 2), r = k & 3; item = (pair >> 1) * 8 + (pair & 1) * 4 + r; }
            ssd_item(a, lds, item, tid, lane, wave);
        }
    }
    else { gmlp_items(a, lds, bx - half, G - half, tid, lane, wave); LBAR(); convert_late_weights(a, lds, (bx - half) * NWAVES + wave, (G - half) * NWAVES, lane, wave); }
}

__device__ __forceinline__ void phase_fixup(const Args& a, int lane, int wave, int G) {
    bf16* MIX = (bf16*)(a.ws + WS_MIX); const float* SSQ = (const float*)(a.ws + WS_SSQ);
    const int gw = blockIdx.x * NWAVES + wave, NGW = G * NWAVES;
    for (int m = gw; m < T; m += NGW) {
        const f32x4 q = *(const f32x4*)(SSQ + (size_t)m * 8 + (lane >> 5) * 4);
        const float sc = 1.0f / sqrtf(((q.x + q.y) + (q.z + q.w)) * (1.f / 256.f) + EPS);
        u32x4* p = (u32x4*)(MIX + (size_t)m * DM + 512) + lane;
        u32x4 v = *p;
        v.x = cvt_pk(bf_lo(v.x) * sc, bf_hi(v.x) * sc); v.y = cvt_pk(bf_lo(v.y) * sc, bf_hi(v.y) * sc);
        v.z = cvt_pk(bf_lo(v.z) * sc, bf_hi(v.z) * sc); v.w = cvt_pk(bf_lo(v.w) * sc, bf_hi(v.w) * sc);
        *p = v;
    }
}

__device__ __forceinline__ void phase_norm1(const Args& a, int lane, int wave, int G) {
    const bf16* OB = (const bf16*)(a.ws + WS_DN); bf16* X1B = (bf16*)(a.ws + WS_X1B); bf16* H = (bf16*)(a.ws + WS_H);
    const int gw = blockIdx.x * NWAVES + wave, NGW = G * NWAVES;
    f32x4 wp[4], wf[4];
#pragma unroll
    for (int j = 0; j < 4; ++j) { wp[j] = *(const f32x4*)(a.norm_mix_post + 256 * j + 4 * lane); wf[j] = *(const f32x4*)(a.norm_ffn_pre + 256 * j + 4 * lane); }
    u32x2 o[4], on[4], onn[4]; f32x4 x[4], xn[4], xnn[4];
#pragma unroll
    for (int j = 0; j < 4; ++j) { on[j] = (u32x2){0u, 0u}; onn[j] = on[j]; xn[j] = (f32x4){0.f, 0.f, 0.f, 0.f}; xnn[j] = xn[j]; }
#define N1_LOAD(dst_o, dst_x, row) do { const u32x2* op_ = (const u32x2*)(OB + (size_t)(row) * DM) + lane; const f32x4* xp_ = (const f32x4*)(a.x + (size_t)(row) * DM) + lane; \
        _Pragma("unroll") for (int j_ = 0; j_ < 4; ++j_) { dst_o[j_] = __builtin_nontemporal_load(op_ + 64 * j_); dst_x[j_] = __builtin_nontemporal_load(xp_ + 64 * j_); } } while (0)
    if (gw < T) N1_LOAD(on, xn, gw);
    if (gw + NGW < T) N1_LOAD(onn, xnn, gw + NGW);
    for (int m = gw; m < T; m += NGW) {
#pragma unroll
        for (int j = 0; j < 4; ++j) { o[j] = on[j]; x[j] = xn[j]; on[j] = onn[j]; xn[j] = xnn[j]; }
        if (m + 2 * NGW < T) N1_LOAD(onn, xnn, m + 2 * NGW);
        f32x4 v[4]; float s = 0.f;
#pragma unroll
        for (int j = 0; j < 4; ++j) { v[j] = (f32x4){bf_lo(o[j].x), bf_hi(o[j].x), bf_lo(o[j].y), bf_hi(o[j].y)}; s += (v[j].x * v[j].x + v[j].y * v[j].y) + (v[j].z * v[j].z + v[j].w * v[j].w); }
        const float r = __builtin_amdgcn_rsqf(wave_sum(s) * (1.f / DM) + EPS);
        float s2 = 0.f;
        u32x2* xo = (u32x2*)(X1B + (size_t)m * DM) + lane;
#pragma unroll
        for (int j = 0; j < 4; ++j) { v[j] = x[j] + v[j] * r * wp[j]; u32x2 w; w.x = cvt_pk(v[j].x, v[j].y); w.y = cvt_pk(v[j].z, v[j].w); __builtin_nontemporal_store(w, xo + 64 * j);
            s2 += (v[j].x * v[j].x + v[j].y * v[j].y) + (v[j].z * v[j].z + v[j].w * v[j].w); }
        const float r2 = __builtin_amdgcn_rsqf(wave_sum(s2) * (1.f / DM) + EPS);
        u32x2* ho = (u32x2*)(H + (size_t)m * DM) + lane;
#pragma unroll
        for (int j = 0; j < 4; ++j) { const f32x4 hv = v[j] * r2 * wf[j]; u32x2 w; w.x = cvt_pk(hv.x, hv.y); w.y = cvt_pk(hv.z, hv.w); ho[64 * j] = w; }
    }
#undef N1_LOAD
}

__device__ __forceinline__ void phase_norm2(const Args& a, int lane, int wave, int G) {
    const bf16* DN = (const bf16*)(a.ws + WS_DN); const bf16* X1B = (const bf16*)(a.ws + WS_X1B);
    const int gw = blockIdx.x * NWAVES + wave, NGW = G * NWAVES;
    f32x4 wp[4];
#pragma unroll
    for (int j = 0; j < 2; ++j) { wp[2 * j] = *(const f32x4*)(a.norm_ffn_post + 512 * j + 8 * lane); wp[2 * j + 1] = *(const f32x4*)(a.norm_ffn_post + 512 * j + 8 * lane + 4); }
    u32x4 d[2], x[2], dn[2], xn[2], dnn[2], xnn[2];
#pragma unroll
    for (int j = 0; j < 2; ++j) { dn[j] = (u32x4){0u, 0u, 0u, 0u}; xn[j] = dn[j]; dnn[j] = dn[j]; xnn[j] = dn[j]; }
#define N2_LOAD(dst_d, dst_x, row) do { const u32x4* dp_ = (const u32x4*)(DN + (size_t)(row) * DM) + lane; const u32x4* xp_ = (const u32x4*)(X1B + (size_t)(row) * DM) + lane; \
        dst_d[0] = __builtin_nontemporal_load(dp_); dst_d[1] = __builtin_nontemporal_load(dp_ + 64); dst_x[0] = __builtin_nontemporal_load(xp_); dst_x[1] = __builtin_nontemporal_load(xp_ + 64); } while (0)
    if (gw < T) N2_LOAD(dn, xn, gw);
    if (gw + NGW < T) N2_LOAD(dnn, xnn, gw + NGW);
    for (int m = gw; m < T; m += NGW) {
#pragma unroll
        for (int j = 0; j < 2; ++j) { d[j] = dn[j]; x[j] = xn[j]; dn[j] = dnn[j]; xn[j] = xnn[j]; }
        if (m + 2 * NGW < T) N2_LOAD(dnn, xnn, m + 2 * NGW);
        float dv[16], s = 0.f;
#pragma unroll
        for (int j = 0; j < 2; ++j)
#pragma unroll
            for (int k = 0; k < 4; ++k) { dv[8 * j + 2 * k] = bf_lo(d[j][k]); dv[8 * j + 2 * k + 1] = bf_hi(d[j][k]); }
#pragma unroll
        for (int i = 0; i < 16; ++i) s += dv[i] * dv[i];
        const float r = __builtin_amdgcn_rsqf(wave_sum(s) * (1.f / DM) + EPS);
        float* orow = a.out + (size_t)m * DM + 8 * lane;
#pragma unroll
        for (int j = 0; j < 2; ++j) {
            f32x4 o0, o1;
            o0.x = bf_lo(x[j].x) + dv[8 * j + 0] * r * wp[2 * j].x; o0.y = bf_hi(x[j].x) + dv[8 * j + 1] * r * wp[2 * j].y;
            o0.z = bf_lo(x[j].y) + dv[8 * j + 2] * r * wp[2 * j].z; o0.w = bf_hi(x[j].y) + dv[8 * j + 3] * r * wp[2 * j].w;
            o1.x = bf_lo(x[j].z) + dv[8 * j + 4] * r * wp[2 * j + 1].x; o1.y = bf_hi(x[j].z) + dv[8 * j + 5] * r * wp[2 * j + 1].y;
            o1.z = bf_lo(x[j].w) + dv[8 * j + 6] * r * wp[2 * j + 1].z; o1.w = bf_hi(x[j].w) + dv[8 * j + 7] * r * wp[2 * j + 1].w;
            __builtin_nontemporal_store(o0, (f32x4*)(orow + 512 * j)); __builtin_nontemporal_store(o1, (f32x4*)(orow + 512 * j + 4));
        }
    }
#undef N2_LOAD
}

constexpr int N_PHASES = 10;
__global__ void __launch_bounds__(NTHR, 2) fwd_megakernel(Args args) {
    extern __shared__ __attribute__((aligned(16))) unsigned char lds_raw[];
    LAS unsigned char* lds = (LAS unsigned char*)lds_raw;
    const int tid = threadIdx.x, lane = tid & 63, wave = __builtin_amdgcn_readfirstlane(tid >> 6), G = gridDim.x;
    const int lo = args.ph_lo, hi = args.ph_hi;
    unsigned char* ws = args.ws;
    volatile LAS unsigned* MISC = (volatile LAS unsigned*)(lds + MISC_OFF);
    if (tid < 32) MISC[tid] = 0u;
    __syncthreads();
#if MK_N_LAUNCHES == 1
    const XcdBarrier bar = xcd_barrier_post((unsigned*)(ws + WS_CTL), MISC + 8);
#endif
    bf16* Win_t = (bf16*)(ws + WS_WIN); bf16* Wout_t = (bf16*)(ws + WS_WOUT); bf16* Wup_t = (bf16*)(ws + WS_WUP); bf16* Wdn_t = (bf16*)(ws + WS_WDN);
    bf16* H = (bf16*)(ws + WS_H); bf16* P = (bf16*)(ws + WS_P); bf16* MIX = (bf16*)(ws + WS_MIX); bf16* F = (bf16*)(ws + WS_F); float* O = (float*)(ws + WS_O);
#define IN(k) (lo <= (k) && (k) < hi)
#if MK_N_LAUNCHES == 1
#define SEAM(k) do { if (IN(k) && IN((k) + 1)) { if (lo < 0) cg::this_grid().sync(); else xcd_barrier(bar); } } while (0)
#else
#define SEAM(k) do { } while (0)
#endif
    if (IN(0)) { phase_prologue(args, lds, tid, lane, wave, G); }
    SEAM(0);
    if (IN(1)) {
        __syncthreads();
        pg8::Gemm g{H, Win_t, T, NP, DM}; pg8::StaticOrder S; S.init(T, NP, G, (int)blockIdx.x);
        pg8::EpiBf16<0> E{P, NP, nullptr, 0, 0, 1.f};
        pg8::gemm_phase<pg8::EpiBf16<0>, pg8::StaticOrder, true, true>(lds, g, S, E);
    }
    SEAM(1);
    if (IN(2)) { phase_conv(args, tid, G); }
    SEAM(2);
    if (IN(3)) { phase_mixer(args, lds, tid, lane, wave, G); }
    SEAM(4);
    if (IN(5)) {
        __syncthreads();
        pg8::Gemm g{MIX, Wout_t, T, DM, DM}; pg8::StaticOrder S; S.init(T, DM, G, (int)blockIdx.x);
        pg8::EpiBf16K E{(bf16*)(ws + WS_DN), DM, (const float*)(ws + WS_SSQ), lds + 131072};
        pg8::gemm_phase<pg8::EpiBf16K, pg8::StaticOrder, true, true>(lds, g, S, E);
    }
    SEAM(5);
    if (IN(6)) { phase_norm1(args, lane, wave, G); }
    SEAM(6);
    if (IN(7)) {
        __syncthreads();
        pg8::Gemm g{H, Wup_t, T, FF, DM}; pg8::StaticOrder S; S.init(T, FF, G, (int)blockIdx.x);
        pg8::EpiBf16<2> E{F, FF, nullptr, 0, 0, 1.f};
        pg8::gemm_phase<pg8::EpiBf16<2>, pg8::StaticOrder, true, true>(lds, g, S, E);
    }
    SEAM(7);
    if (IN(8)) {
        __syncthreads();
        pg8::Gemm g{F, Wdn_t, T, DM, FF}; pg8::StaticOrder S; S.init(T, DM, G, (int)blockIdx.x);
        pg8::EpiBf16<0> E{(bf16*)(ws + WS_DN), DM, nullptr, 0, 0, 1.f};
        pg8::gemm_phase<pg8::EpiBf16<0>, pg8::StaticOrder, true, true>(lds, g, S, E);
    }
    SEAM(8);
    if (IN(9)) { phase_norm2(args, lane, wave, G); }
#undef IN
#undef SEAM
}

extern "C" void kernel_launch(void* const* d_in, const int* in_sizes, int n_in, void* d_out, int out_size, void* d_ws, size_t ws_size, hipStream_t stream) {
    static int grid = 0;
    if (grid == 0) {
        if (n_in != 19 || out_size != T * DM || ws_size < WS_END) { fprintf(stderr, "kernel_launch: unexpected sizes n_in %d out %d ws %zu\n", n_in, out_size, ws_size); grid = -1; return; }
        int dev = 0, cus = 0, per_cu = 0;
        (void)hipGetDevice(&dev); (void)hipDeviceGetAttribute(&cus, hipDeviceAttributeMultiprocessorCount, dev);
        if (hipFuncSetAttribute((const void*)fwd_megakernel, hipFuncAttributeMaxDynamicSharedMemorySize, LDS_BYTES) != hipSuccess) { fprintf(stderr, "kernel_launch: hipFuncSetAttribute failed\n"); grid = -1; return; }
        if (hipOccupancyMaxActiveBlocksPerMultiprocessor(&per_cu, (const void*)fwd_megakernel, NTHR, LDS_BYTES) != hipSuccess || per_cu < 1) { fprintf(stderr, "kernel_launch: occupancy query says %d\n", per_cu); per_cu = 1; }
        (void)hipGetLastError();
        grid = cus >= 256 ? 256 : (cus / 16) * 16;
        if (grid < 16) { fprintf(stderr, "kernel_launch: too few CUs (%d)\n", cus); grid = -1; return; }
        fprintf(stderr, "kernel_launch: grid %d (cus %d, per_cu %d)\n", grid, cus, per_cu);
    }
    if (grid < 0) return;
    Args a{};
    const float** ap = (const float**)&a;
    for (int i = 0; i < 19; ++i) ap[i] = (const float*)d_in[i];
    a.out = (float*)d_out; a.ws = (unsigned char*)d_ws;
#if MK_N_LAUNCHES == 1
    if (hipMemsetAsync((char*)d_ws + WS_CTL, 0, CTL_ZERO_BYTES, stream) != hipSuccess) { fprintf(stderr, "kernel_launch: memset failed\n"); return; }
    a.ph_lo = 0; a.ph_hi = N_PHASES;
    void* kargs[] = {&a};
    hipError_t e = hipLaunchCooperativeKernel((const void*)fwd_megakernel, dim3(grid), dim3(NTHR), kargs, LDS_BYTES, stream);
    if (e != hipSuccess) fprintf(stderr, "kernel_launch: cooperative launch failed: %s (grid %d)\n", hipGetErrorString(e), grid);
#else
    for (int ph = 0; ph < N_PHASES; ++ph) {
        a.ph_lo = ph; a.ph_hi = ph + 1;
        hipLaunchKernelGGL(fwd_megakernel, dim3(grid), dim3(NTHR), LDS_BYTES, stream, a);
    }
#endif
}
```

```cpp
#include <hip/hip_runtime.h>
#include <hip/hip_cooperative_groups.h>
#include <cstdio>
#include <cstdint>
namespace pg8 {
#define PG8_LAS __attribute__((address_space(3)))
typedef unsigned short bf16_t;
typedef short bf16x8 __attribute__((ext_vector_type(8)));
typedef float f32x4 __attribute__((ext_vector_type(4)));
typedef unsigned u32x4 __attribute__((ext_vector_type(4)));
constexpr int BM = 256, BK = 64, HALF = 128, HTB = HALF * BK * 2  , STAGE_BYTES = 8 * HTB, NXCD = 8, WGM = 8;

__host__ __device__ __forceinline__ int lds_byte(int r, int c) { const int st = (r >> 4) * 2 + (c >> 5), rr = r & 15, cc = c & 31, ob = rr * 64 + cc * 2; return st * 1024 + (ob ^ (((ob >> 9) & 1) << 5)); }
__host__ __device__ __forceinline__ void stage_rc(int b, int& R, int& C) { const int st = b / 1024, sb = b % 1024, swz = sb ^ (((sb >> 9) & 1) << 5); R = (st >> 1) * 16 + swz / 64; C = (st & 1) * 32 + (swz % 64) / 2; }
__host__ __device__ __forceinline__ int perm32(int rho) { const int n = rho >> 4, i = rho & 15; return 8 * (i >> 2) + 4 * n + (i & 3); }

struct Unit { int pm, pn; };
struct Gemm { const bf16_t* A; const bf16_t* Bt; int M, N, K; };

struct StaticOrder {
    int nM, nN, nwg, G, c;
    __host__ __device__ void init(int M, int N, int G_, int c_) { nM = M / BM; nN = N / BM; nwg = nM * nN; G = G_; c = c_; }
    __host__ __device__ bool next(int i, Unit& u) const {
        const long L = (long)i * G + c; if (L >= nwg) return false;
        int wgid = (int)L; { const int q = nwg / NXCD, r = nwg % NXCD, xcd = wgid % NXCD, off = wgid / NXCD; wgid = (xcd < r ? xcd * (q + 1) : r * (q + 1) + (xcd - r) * q) + off; }
        const int nig = WGM * nN, gid = wgid / nig, fm = gid * WGM, gsz = (nM - fm) < WGM ? (nM - fm) : WGM;
        u.pm = fm + ((wgid % nig) % gsz); u.pn = (wgid % nig) / gsz; return true;
    }
    __device__ __forceinline__ void a_ready(const Unit&) const {}
    __device__ __forceinline__ void done(const Unit&) const {}
};

struct RoundOrder {
    StaticOrder so; int r;
    __host__ __device__ bool next(int i, Unit& u) const { return i == 0 && so.next(r, u); }
    __device__ __forceinline__ void a_ready(const Unit&) const {}
    __device__ __forceinline__ void done(const Unit&) const {}
};
__device__ __forceinline__ unsigned cvt_pk_bf16(float lo, float hi) { unsigned r; asm volatile("v_cvt_pk_bf16_f32 %0, %1, %2" : "=v"(r) : "v"(lo), "v"(hi)); return r; }
typedef float f32x2 __attribute__((ext_vector_type(2)));
__device__ __forceinline__ f32x2 gelu_pk(f32x2 v) {
    const f32x2 av = __builtin_elementwise_abs(v), d = av * 0.2316418882f + 1.0f;
    f32x2 t; t.x = __builtin_amdgcn_rcpf(d.x); t.y = __builtin_amdgcn_rcpf(d.y);
    f32x2 q = t * 0.5307027145f + (-0.7265760135f); q = q * t + 0.7107068705f; q = q * t + (-0.142248368f); q = q * t + 0.127414796f; q = q * t;
    const f32x2 s = (v * v) * (-0.72134752044f);
    f32x2 e; e.x = __builtin_amdgcn_exp2f(s.x); e.y = __builtin_amdgcn_exp2f(s.y);
    const f32x2 m = v * (q * e), r = v - m;
    f32x2 o; o.x = v.x < 0.f ? m.x : r.x; o.y = v.y < 0.f ? m.y : r.y; return o;
}

template <int ACT  > struct EpiBf16 {
    static constexpr bool PERM = true, AFTER_DRAIN = false, KSCALE = false; static_assert(ACT == 0 || ACT == 1 || ACT == 2, "EpiBf16: ACT 0 none, 1 gelu_pk, 2 relu^2");
    bf16_t* O; int ldc; const float* bias; int split_cols; size_t split_stride; float scale0;
    __device__ __forceinline__ void operator()(const f32x4 (&acc)[2][2][4][2], const Unit& u, int wr, int wc, int fr, int fq) const {
        const int row0 = u.pm * BM + wr * 64 + fr; int colt = u.pn * BM; bf16_t* base = O;
        float sc = 1.f; if (split_cols) { const int t = colt / split_cols; base += (size_t)t * split_stride; colt -= t * split_cols; if (t == 0) sc = scale0; }
        const int col0 = colt + wc * 32 + 8 * fq, bcol0 = u.pn * BM + wc * 32 + 8 * fq;
        f32x4 bv[2][2];
#pragma unroll
        for (int bj = 0; bj < 2; ++bj)
#pragma unroll
            for (int n = 0; n < 2; ++n) bv[bj][n] = bias ? *(const f32x4*)(bias + bcol0 + bj * HALF + 4 * n) : (f32x4){0.f, 0.f, 0.f, 0.f};
#pragma unroll
        for (int ai = 0; ai < 2; ++ai)
#pragma unroll
            for (int m = 0; m < 4; ++m) { bf16_t* rowp = base + (size_t)(row0 + ai * HALF + m * 16) * ldc + col0;
#pragma unroll
                for (int bj = 0; bj < 2; ++bj) { f32x4 v0 = acc[ai][bj][m][0] + bv[bj][0], v1 = acc[ai][bj][m][1] + bv[bj][1];
                    if (ACT == 1) { f32x2 a = gelu_pk((f32x2){v0[0], v0[1]}), b = gelu_pk((f32x2){v0[2], v0[3]}), c = gelu_pk((f32x2){v1[0], v1[1]}), d = gelu_pk((f32x2){v1[2], v1[3]});
                        v0 = (f32x4){a.x, a.y, b.x, b.y}; v1 = (f32x4){c.x, c.y, d.x, d.y}; }
                    if (ACT == 2) { v0 = __builtin_elementwise_max(v0, (f32x4){0.f, 0.f, 0.f, 0.f}); v1 = __builtin_elementwise_max(v1, (f32x4){0.f, 0.f, 0.f, 0.f}); v0 = v0 * v0; v1 = v1 * v1; }
                    v0 = v0 * sc; v1 = v1 * sc; u32x4 w; w.x = cvt_pk_bf16(v0[0], v0[1]); w.y = cvt_pk_bf16(v0[2], v0[3]); w.z = cvt_pk_bf16(v1[0], v1[1]); w.w = cvt_pk_bf16(v1[2], v1[3]);
                    *(u32x4*)(rowp + bj * HALF) = w; } }
    }
};

struct EpiF32 {
    static constexpr bool PERM = false, AFTER_DRAIN = false, KSCALE = false;
    float* O; int ldc;
    __device__ __forceinline__ void operator()(const f32x4 (&acc)[2][2][4][2], const Unit& u, int wr, int wc, int fr, int fq) const {
        const int col0 = u.pn * BM + wc * 32 + 4 * fq;
#pragma unroll
        for (int ai = 0; ai < 2; ++ai)
#pragma unroll
            for (int m = 0; m < 4; ++m) { const size_t off = (size_t)(u.pm * BM + ai * HALF + wr * 64 + m * 16 + fr) * ldc + col0;
#pragma unroll
                for (int bj = 0; bj < 2; ++bj)
#pragma unroll
                    for (int n = 0; n < 2; ++n) *(f32x4*)(O + off + bj * HALF + n * 16) = acc[ai][bj][m][n]; }
    }
};

struct EpiBf16K {
    static constexpr bool PERM = true, AFTER_DRAIN = false, KSCALE = true;
    bf16_t* O; int ldc; const float* ssq;
    PG8_LAS unsigned char* tab;
    __device__ __forceinline__ void ksetup(const Unit& u) const {
        PG8_LAS f32x4* T = (PG8_LAS f32x4*)(tab + ((u.pm >> 3) & 1) * 4096);
        const int tid = threadIdx.x;
        if (tid < 256) {
            const float* q = ssq + (size_t)(u.pm * BM + tid) * 8;
            const f32x4 q0 = *(const f32x4*)q, q1 = *(const f32x4*)(q + 4);
            const float ms0 = ((q0[0] + q0[1]) + (q0[2] + q0[3])) * (1.0f / 256.0f) + 1e-6f, ms1 = ((q1[0] + q1[1]) + (q1[2] + q1[3])) * (1.0f / 256.0f) + 1e-6f;
            const float r0 = __builtin_amdgcn_rsqf(ms0), r1 = __builtin_amdgcn_rsqf(ms1);
            T[tid] = (f32x4){ms0 * r0, ms1 * r1 * r0, r1, 0.f};
        }
    }
    __device__ __forceinline__ void kscale(f32x4 (&acc)[2][2][4][2], const Unit& u, int t, int wr, int fr) const {
        PG8_LAS f32x4* T = (PG8_LAS f32x4*)(tab + ((u.pm >> 3) & 1) * 4096);
        int rbase = wr * 64 + fr; asm volatile("" : "+v"(rbase));
#pragma unroll
        for (int ai = 0; ai < 2; ++ai)
#pragma unroll
            for (int m = 0; m < 4; ++m) {
                const f32x4 tv = T[rbase + ai * HALF + m * 16];
                const float f = (t == 8) ? tv[0] : tv[1];
#pragma unroll
                for (int bj = 0; bj < 2; ++bj)
#pragma unroll
                    for (int n = 0; n < 2; ++n) acc[ai][bj][m][n] = acc[ai][bj][m][n] * f;
            }
    }
    __device__ __forceinline__ void operator()(const f32x4 (&acc)[2][2][4][2], const Unit& u, int wr, int wc, int fr, int fq) const {
        const PG8_LAS f32x4* T = (const PG8_LAS f32x4*)(tab + ((u.pm >> 3) & 1) * 4096);
        const int rl0 = wr * 64 + fr, col0 = u.pn * BM + wc * 32 + 8 * fq;
#pragma unroll
        for (int ai = 0; ai < 2; ++ai)
#pragma unroll
            for (int m = 0; m < 4; ++m) { const int rl = rl0 + ai * HALF + m * 16; bf16_t* rowp = O + (size_t)(u.pm * BM + rl) * ldc + col0;
                const float f = T[rl][2];
#pragma unroll
                for (int bj = 0; bj < 2; ++bj) { const f32x4 v0 = acc[ai][bj][m][0] * f, v1 = acc[ai][bj][m][1] * f;
                    u32x4 w; w.x = cvt_pk_bf16(v0[0], v0[1]); w.y = cvt_pk_bf16(v0[2], v0[3]); w.z = cvt_pk_bf16(v1[0], v1[1]); w.w = cvt_pk_bf16(v1[2], v1[3]);
                    *(u32x4*)(rowp + bj * HALF) = w; } }
    }
};
template <class Epi, class Sched, bool ALIGN_EPI = false, bool SP2 = false>
__device__ __forceinline__ void gemm_phase(PG8_LAS unsigned char* lds, const Gemm g, const Sched& S, const Epi& E) {
    const int tid = threadIdx.x, wid = __builtin_amdgcn_readfirstlane(tid >> 6), lane = tid & 63, wr = wid >> 2, wc = wid & 3, fr = lane & 15, fq = lane >> 4;
    const int K = g.K, nt = K / BK;
    unsigned voffA[2], voffB[2];
#pragma unroll
    for (int i = 0; i < 2; ++i) { int R, C; stage_rc(tid * 16 + i * 8192, R, C); const int Rb = Epi::PERM ? ((R & ~31) + perm32(R & 31)) : R;
        voffA[i] = (unsigned)(R * K + C) * 2u; voffB[i] = (unsigned)(Rb * K + C) * 2u; }
    const size_t kstep = (size_t)(BK * 2);
    const size_t hstep = (size_t)HALF * K * 2;
    const size_t tstep = 2 * hstep;
    const unsigned ldsw = (unsigned)wid * 1024u;
    const int aoff = lds_byte(wr * 64 + fr, fq * 8), boff = lds_byte(wc * 32 + fr, fq * 8);
#define PG8_SA(b, h) (((b) * 2 + (h)) * HTB)
#define PG8_SB(b, h) ((4 + (b) * 2 + (h)) * HTB)
#define PG8_STAGE(bufoff, gbase, voff) do { _Pragma("unroll") for (int _i = 0; _i < 2; ++_i) \
        __builtin_amdgcn_global_load_lds((const unsigned*)((const char*)(gbase) + (voff)[_i]), (PG8_LAS unsigned*)(lds + (bufoff) + ldsw + _i * 8192), 16, 0, 0); } while (0)
#define PG8_LDA(dst, b, h) do { _Pragma("unroll") for (int m = 0; m < 4; ++m) _Pragma("unroll") for (int k = 0; k < 2; ++k) dst[m][k] = *(const PG8_LAS bf16x8*)(lds + PG8_SA(b, h) + aoff + m * 2048 + k * 1024); } while (0)
#define PG8_LDB(dst, b, h) do { _Pragma("unroll") for (int n = 0; n < 2; ++n) _Pragma("unroll") for (int k = 0; k < 2; ++k) dst[n][k] = *(const PG8_LAS bf16x8*)(lds + PG8_SB(b, h) + boff + n * 2048 + k * 1024); } while (0)
#define PG8_MMA(ai, bj, At, Bt) do { __builtin_amdgcn_s_setprio(1); _Pragma("unroll") for (int m = 0; m < 4; ++m) _Pragma("unroll") for (int n = 0; n < 2; ++n) _Pragma("unroll") for (int k = 0; k < 2; ++k) \
        acc[ai][bj][m][n] = __builtin_amdgcn_mfma_f32_16x16x32_bf16(Bt[n][k], At[m][k], acc[ai][bj][m][n], 0, 0, 0); __builtin_amdgcn_s_setprio(0); } while (0)
#define PG8_WAIT_V(n) asm volatile("s_waitcnt vmcnt(" #n ")" ::: "memory")
#define PG8_WAIT_L(n) asm volatile("s_waitcnt lgkmcnt(" #n ")" ::: "memory")
#define PG8_BAR __builtin_amdgcn_s_barrier()
#define PG8_SCHED __builtin_amdgcn_sched_barrier(0)
    Unit cur, nxt; int ui = 0;
    if (!S.next(0, cur)) return;
    if constexpr (Epi::KSCALE) E.ksetup(cur);
    f32x4 acc[2][2][4][2];
#pragma unroll
    for (int a = 0; a < 2; ++a)
#pragma unroll
        for (int b = 0; b < 2; ++b)
#pragma unroll
            for (int m = 0; m < 4; ++m)
#pragma unroll
                for (int n = 0; n < 2; ++n) acc[a][b][m][n] = (f32x4){0.f, 0.f, 0.f, 0.f};
    bf16x8 At[4][2], B0[2][2], B1[2][2];
    const char* cA = (const char*)g.A + (size_t)cur.pm * tstep; const char* cB = (const char*)g.Bt + (size_t)cur.pn * tstep;
    S.a_ready(cur);
    if constexpr (SP2) {
        PG8_STAGE(PG8_SB(0, 0), cB, voffB); PG8_STAGE(PG8_SB(0, 1), cB + hstep, voffB); PG8_STAGE(PG8_SA(0, 0), cA, voffA); PG8_STAGE(PG8_SA(0, 1), cA + hstep, voffA);
        if (wr == 1) PG8_BAR;
        PG8_WAIT_V(2); PG8_BAR;
        PG8_STAGE(PG8_SB(1, 0), cB + kstep, voffB); PG8_STAGE(PG8_SA(1, 0), cA + kstep, voffA); PG8_STAGE(PG8_SB(1, 1), cB + hstep + kstep, voffB);
        PG8_WAIT_V(6); PG8_BAR;
    } else {
        PG8_STAGE(PG8_SB(0, 0), cB, voffB); PG8_STAGE(PG8_SA(0, 0), cA, voffA); PG8_STAGE(PG8_SB(0, 1), cB + hstep, voffB); PG8_STAGE(PG8_SA(0, 1), cA + hstep, voffA);
        if (wr == 1) PG8_BAR;
        PG8_WAIT_V(4); PG8_BAR;
        PG8_STAGE(PG8_SB(1, 0), cB + kstep, voffB); PG8_STAGE(PG8_SA(1, 0), cA + kstep, voffA); PG8_STAGE(PG8_SB(1, 1), cB + hstep + kstep, voffB);
        PG8_WAIT_V(6); PG8_BAR;
    }
    for (;;) {
        const bool has_next = S.next(ui + 1, nxt);
        const char* nA = has_next ? (const char*)g.A + (size_t)nxt.pm * tstep : cA; const char* nB = has_next ? (const char*)g.Bt + (size_t)nxt.pn * tstep : cB;
        for (int t = 0; t < nt; t += 2) {
            if constexpr (Epi::KSCALE) { if (t == 8 || t == 12) E.kscale(acc, cur, t, wr, fr); }
            const bool last = (t == nt - 2);
            const char* a1 = cA + (size_t)(t + 1) * kstep;
            const char* a2 = last ? nA : cA + (size_t)(t + 2) * kstep; const char* b2 = last ? nB : cB + (size_t)(t + 2) * kstep;
            const char* a3 = a2 + kstep; const char* b3 = b2 + kstep;
            if (last && has_next) S.a_ready(nxt);
            if constexpr (SP2) {
            PG8_LDB(B0, 0, 0); PG8_LDB(B1, 0, 1); PG8_SCHED; PG8_LDA(At, 0, 0); PG8_STAGE(PG8_SA(1, 1), a1 + hstep, voffA);
            PG8_WAIT_V(8); PG8_WAIT_L(0); PG8_BAR; PG8_MMA(0, 0, At, B0); PG8_MMA(0, 1, At, B1); PG8_BAR; PG8_SCHED;
            PG8_LDA(At, 0, 1); PG8_STAGE(PG8_SB(0, 0), b2, voffB); PG8_STAGE(PG8_SB(0, 1), b2 + hstep, voffB); PG8_STAGE(PG8_SA(0, 0), a2, voffA);
            PG8_WAIT_V(8); PG8_WAIT_L(0); PG8_BAR; PG8_MMA(1, 0, At, B0); PG8_MMA(1, 1, At, B1); PG8_BAR; PG8_SCHED;
            PG8_LDB(B0, 1, 0); PG8_LDB(B1, 1, 1); PG8_SCHED; PG8_LDA(At, 1, 0); PG8_STAGE(PG8_SA(0, 1), a2 + hstep, voffA);
            PG8_WAIT_V(8); PG8_WAIT_L(0); PG8_BAR; PG8_MMA(0, 0, At, B0); PG8_MMA(0, 1, At, B1); PG8_BAR; PG8_SCHED;
            PG8_LDA(At, 1, 1); PG8_STAGE(PG8_SB(1, 0), b3, voffB); PG8_STAGE(PG8_SB(1, 1), b3 + hstep, voffB); PG8_STAGE(PG8_SA(1, 0), a3, voffA);
            PG8_WAIT_V(8); PG8_WAIT_L(0); PG8_BAR; PG8_MMA(1, 0, At, B0); PG8_MMA(1, 1, At, B1); PG8_BAR; PG8_SCHED;
            } else {
            PG8_LDB(B0, 0, 0); PG8_SCHED; PG8_LDA(At, 0, 0); PG8_STAGE(PG8_SA(1, 1), a1 + hstep, voffA);
            PG8_WAIT_L(8); PG8_BAR; PG8_WAIT_L(0); PG8_MMA(0, 0, At, B0); PG8_BAR; PG8_SCHED;
            PG8_LDB(B1, 0, 1); PG8_STAGE(PG8_SB(0, 0), b2, voffB);
            PG8_BAR; PG8_WAIT_L(0); PG8_MMA(0, 1, At, B1); PG8_BAR;
            PG8_LDA(At, 0, 1); PG8_STAGE(PG8_SA(0, 0), a2, voffA);
            PG8_BAR; PG8_WAIT_L(0); PG8_MMA(1, 0, At, B0); PG8_BAR; PG8_SCHED;
            PG8_STAGE(PG8_SB(0, 1), b2 + hstep, voffB);
            PG8_WAIT_V(6); PG8_BAR; PG8_MMA(1, 1, At, B1); PG8_BAR;
            PG8_LDB(B0, 1, 0); PG8_SCHED; PG8_LDA(At, 1, 0); PG8_STAGE(PG8_SA(0, 1), a2 + hstep, voffA);
            PG8_WAIT_L(8); PG8_BAR; PG8_WAIT_L(0); PG8_MMA(0, 0, At, B0); PG8_BAR; PG8_SCHED;
            PG8_LDB(B1, 1, 1); PG8_STAGE(PG8_SB(1, 0), b3, voffB);
            PG8_BAR; PG8_WAIT_L(0); PG8_MMA(0, 1, At, B1); PG8_BAR;
            PG8_LDA(At, 1, 1); PG8_STAGE(PG8_SA(1, 0), a3, voffA);
            PG8_BAR; PG8_WAIT_L(0); PG8_MMA(1, 0, At, B0); PG8_BAR; PG8_SCHED;
            PG8_STAGE(PG8_SB(1, 1), b3 + hstep, voffB);
            PG8_WAIT_V(6); PG8_BAR; PG8_MMA(1, 1, At, B1); PG8_BAR;
            }
        }
        if constexpr (ALIGN_EPI) { if (wr == 0) PG8_BAR; }
        if constexpr (!Epi::AFTER_DRAIN) { E(acc, cur, wr, wc, fr, fq); S.done(cur); }
        if (!has_next) break;
#pragma unroll
        for (int a = 0; a < 2; ++a)
#pragma unroll
            for (int b = 0; b < 2; ++b)
#pragma unroll
                for (int m = 0; m < 4; ++m)
#pragma unroll
                    for (int n = 0; n < 2; ++n) acc[a][b][m][n] = (f32x4){0.f, 0.f, 0.f, 0.f};
        cur = nxt; cA = nA; cB = nB; ++ui;
        if constexpr (Epi::KSCALE) E.ksetup(cur);
        if constexpr (ALIGN_EPI) { if (wr == 1) PG8_BAR; }
    }
    PG8_WAIT_V(0);
    if constexpr (!ALIGN_EPI) { if (wr == 0) PG8_BAR; }
    PG8_BAR;
    if constexpr (Epi::AFTER_DRAIN) { E.fused(acc, cur, wr, wc, fr, fq, lds, wid, lane); S.done(cur); }
#undef PG8_SA
#undef PG8_SB
#undef PG8_STAGE
#undef PG8_LDA
#undef PG8_LDB
#undef PG8_MMA
#undef PG8_WAIT_V
#undef PG8_WAIT_L
#undef PG8_BAR
#undef PG8_SCHED
}
}

#ifndef MK_N_LAUNCHES
#define MK_N_LAUNCHES 1
#endif
namespace cg = cooperative_groups;
#define LAS __attribute__((address_space(3)))
typedef unsigned short bf16;
typedef float f32x4 __attribute__((ext_vector_type(4)));
typedef float f32x2 __attribute__((ext_vector_type(2)));
typedef short bf16x8 __attribute__((ext_vector_type(8)));
typedef unsigned u32x4 __attribute__((ext_vector_type(4)));
typedef unsigned u32x2 __attribute__((ext_vector_type(2)));

constexpr int NWAVES = 8, NTHR = 512;
constexpr int NB = 16, SEQ = 2048, T = NB * SEQ, DM = 1024, NP = 2560, LDW_IN = 2568, FF = 4096;
constexpr int CHK = 128, NCH = SEQ / CHK;
constexpr int C_U = 0, C_V = 512, C_Z = 1024, C_X = 1536, C_B = 2048, C_C = 2304;
constexpr float EPS = 1e-6f;
constexpr size_t MiB = 1u << 20;
constexpr size_t WS_WIN = 2 * MiB, WS_WOUT = 8 * MiB, WS_WUP = 10 * MiB, WS_WDN = 18 * MiB, WS_WS = 26 * MiB, WS_DT = 27 * MiB, WS_SSQ = 28 * MiB;
constexpr size_t WS_H = 32 * MiB, WS_P = 96 * MiB, WS_MIX = 256 * MiB, WS_F = 96 * MiB, WS_O = 352 * MiB, WS_XBC = 352 * MiB  , WS_DN = 352 * MiB, WS_X1B = 416 * MiB, WS_END = 480 * MiB;
constexpr int LDS_BYTES = 149504, MISC_OFF = 148480;
constexpr size_t WS_CTL = 0, CTL_ZERO_BYTES = 16384;
constexpr int CW_TMO = 3584, CW_CNT = 4096, CNT_BANK = 128 * 64;

__device__ __forceinline__ unsigned cvt_pk(float lo, float hi) { unsigned r; asm volatile("v_cvt_pk_bf16_f32 %0, %1, %2" : "=v"(r) : "v"(lo), "v"(hi)); return r; }
__device__ __forceinline__ float bf_lo(unsigned w) { return __uint_as_float(w << 16); }
__device__ __forceinline__ float bf_hi(unsigned w) { return __uint_as_float(w & 0xffff0000u); }
__device__ __forceinline__ float wave_sum(float v) {
#pragma unroll
    for (int o = 1; o < 64; o <<= 1) v += __shfl_xor(v, o);
    return v;
}
__device__ __forceinline__ float gelu_tanh(float x) {
    const float y = 1.5957691216057308f * (x + 0.044715f * x * x * x);
    return x * __builtin_amdgcn_rcpf(1.0f + __expf(-y));
}
__device__ __forceinline__ float silu_f(float x) { return x * __builtin_amdgcn_rcpf(1.0f + __expf(-x)); }
#define LBAR() do { asm volatile("s_waitcnt lgkmcnt(0)" ::: "memory"); __builtin_amdgcn_s_barrier(); asm volatile("" ::: "memory"); } while (0)
__device__ __forceinline__ float softplus_f(float x) { return x > 20.f ? x : log1pf(__expf(x)); }

__device__ __forceinline__ void p0_transpose_item(const float* W, int K, int nblk, int ldw, bf16* WT, LAS float* scr, int item, int lane, const float* kscale = nullptr, int kscale_from = 0) {
    const int kb = item / nblk, nb = item % nblk, k0 = 64 * kb, n0 = 32 * nb;
    const float* ks = (kscale && k0 >= kscale_from) ? kscale + (k0 - kscale_from) : nullptr;
#pragma unroll
    for (int i = 0; i < 32; ++i) { const int kk = 2 * i + (lane >> 5); float val = __builtin_nontemporal_load(W + (size_t)(k0 + kk) * ldw + n0 + (lane & 31)); if (ks) val *= ks[kk]; scr[kk * 33 + (lane & 31)] = val; }
    asm volatile("s_waitcnt lgkmcnt(0)" ::: "memory");
    const int c = lane & 7;
#pragma unroll
    for (int j = 0; j < 4; ++j) { const int n = (lane >> 3) + 8 * j; const LAS float* s = scr + (8 * c) * 33 + n;
        u32x4 o; o.x = cvt_pk(s[0 * 33], s[1 * 33]); o.y = cvt_pk(s[2 * 33], s[3 * 33]); o.z = cvt_pk(s[4 * 33], s[5 * 33]); o.w = cvt_pk(s[6 * 33], s[7 * 33]);
        *(u32x4*)(WT + (size_t)(n0 + n) * K + k0 + 8 * c) = o; }
    asm volatile("s_waitcnt lgkmcnt(0)" ::: "memory");
}

#define XB_TMO      128
#define XB_XCNT(j)  (256  + 64 * (j))
#define XB_XSUB(j)  (1280 + 64 * (j))
#define XB_XGEN(j)  (2304 + 64 * (j))
#define XB_TOP      3328
#define XB_TOPGEN   3392
#define XCD_BAR_WORDS 3456
#define XB_SPIN_CAP (1u << 18)

__device__ __forceinline__ unsigned xb_ld(unsigned* p)              { return __hip_atomic_load(p, __ATOMIC_RELAXED, __HIP_MEMORY_SCOPE_AGENT); }
__device__ __forceinline__ unsigned xb_add(unsigned* p, unsigned v) { return __hip_atomic_fetch_add(p, v, __ATOMIC_RELAXED, __HIP_MEMORY_SCOPE_AGENT); }
__device__ __forceinline__ unsigned xb_xcc_id() { return (unsigned)__builtin_amdgcn_s_getreg((3 << 11) | 20) & 0xFu; }
#define XB_SPIN(cond, bar) do { unsigned _sp = 0; while (cond) { __builtin_amdgcn_s_sleep(1); \
    if ((++_sp & 255u) == 0u) { if (xb_ld(&(bar)[XB_TMO])) break; if (_sp > XB_SPIN_CAP) { atomicAdd(&(bar)[XB_TMO], 1u); break; } } } } while (0)

struct XcdBarrier {
    unsigned* bar; unsigned x;
    volatile LAS unsigned* st;
};

__device__ __forceinline__ XcdBarrier xcd_barrier_post(unsigned* bar, volatile LAS unsigned* st) {
    XcdBarrier b; b.bar = bar; b.x = xb_xcc_id(); b.st = st;
    if (threadIdx.x == 0) (void)xb_add(&bar[XB_XCNT(b.x)], 1u);
    return b;
}
__device__ __forceinline__ void xcd_barrier_complete(unsigned* bar, unsigned x, unsigned& nloc, unsigned& nx) {
    const unsigned G = gridDim.x * gridDim.y * gridDim.z;
    unsigned sum, cnt, mine, sp = 0u;
    for (;;) {
        sum = 0u; cnt = 0u; mine = 0u;
#pragma unroll
        for (unsigned j = 0; j < 16; ++j) { const unsigned c = xb_ld(&bar[XB_XCNT(j)]); sum += c; cnt += (c > 0u) ? 1u : 0u; mine = (j == x) ? c : mine; }
        if (sum == G) break;
        __builtin_amdgcn_s_sleep(1);
        if ((++sp & 255u) == 0u) { if (xb_ld(&bar[XB_TMO])) break; if (sp > XB_SPIN_CAP) { atomicAdd(&bar[XB_TMO], 1u); break; } }
    }
    nloc = mine > 0u ? mine : 1u; nx = cnt > 0u ? cnt : 1u;
}

__device__ __forceinline__ void xcd_barrier(const XcdBarrier& b) {
    asm volatile("s_waitcnt vmcnt(0)" ::: "memory");
    __syncthreads();
    if (threadIdx.x == 0) {
        unsigned* bar = b.bar;
        __builtin_amdgcn_s_waitcnt(0);
        unsigned nloc = b.st[0], nx = b.st[1];
        if (nloc == 0u) { xcd_barrier_complete(bar, b.x, nloc, nx); b.st[0] = nloc; b.st[1] = nx; }
        const unsigned old = xb_add(&bar[XB_XSUB(b.x)], 1u);
        const unsigned gen = old / nloc;
        if (old + 1u == (gen + 1u) * nloc) {
            __builtin_amdgcn_fence(__ATOMIC_RELEASE, "agent");
            asm volatile("s_waitcnt vmcnt(0)" ::: "memory");
            const unsigned og = xb_add(&bar[XB_TOP], 1u);
            const unsigned tg = og / nx;
            if (og + 1u == (tg + 1u) * nx) xb_add(&bar[XB_TOPGEN], 1u);
            else XB_SPIN(xb_ld(&bar[XB_TOPGEN]) == tg, bar);
            __builtin_amdgcn_fence(__ATOMIC_ACQUIRE, "agent");
            xb_add(&bar[XB_XGEN(b.x)], 1u);
            asm volatile("s_waitcnt vmcnt(0)" ::: "memory");
        } else {
            XB_SPIN(xb_ld(&bar[XB_XGEN(b.x)]) == gen, bar);
            __builtin_amdgcn_fence(__ATOMIC_ACQUIRE, "agent");
            asm volatile("s_waitcnt vmcnt(0)" ::: "memory");
        }
    }
    __syncthreads();
}

struct Args {
    const float *x, *norm_mix_pre, *w_in, *gm_ln_w, *gm_ln_b, *gm_w_s, *gm_b_s, *conv_w, *conv_b, *dt_bias, *a_log, *d_skip, *ssm_norm_w, *w_out, *norm_mix_post, *norm_ffn_pre, *w_up, *w_down, *norm_ffn_post;
    float* out; unsigned char* ws; int ph_lo, ph_hi;
};

__device__ __forceinline__ void phase_prologue(const Args& a, LAS unsigned char* lds, int tid, int lane, int wave, int G) {
    unsigned char* ws = a.ws;
    bf16* Win_t = (bf16*)(ws + WS_WIN); bf16* Wout_t = (bf16*)(ws + WS_WOUT); bf16* Wup_t = (bf16*)(ws + WS_WUP); bf16* Wdn_t = (bf16*)(ws + WS_WDN);
    bf16* Wsb = (bf16*)(ws + WS_WS); float* DT = (float*)(ws + WS_DT); bf16* H = (bf16*)(ws + WS_H);
    const int gw = blockIdx.x * NWAVES + wave, NGW = G * NWAVES;
    {
        LAS float* scr = (LAS float*)(lds + wave * 16384);
        constexpr int I_IN = (DM / 64) * (NP / 32);
        for (int it = gw; it < I_IN; it += NGW) p0_transpose_item(a.w_in, DM, NP / 32, LDW_IN, Win_t, scr, it, lane);
    }
    for (int i = blockIdx.x * NTHR + tid; i < 8 * 128 * 128 / 4; i += G * NTHR) {
        const int e = i * 4, s0 = e & 127, t = (e >> 7) & 127;
        const f32x4 w = *(const f32x4*)(a.gm_w_s + e);
        u32x2 o; o.x = cvt_pk(s0 + 0 <= t ? w.x : 0.f, s0 + 1 <= t ? w.y : 0.f); o.y = cvt_pk(s0 + 2 <= t ? w.z : 0.f, s0 + 3 <= t ? w.w : 0.f);
        *(u32x2*)(Wsb + e) = o;
    }
    f32x4 wn[4], wd[4][4][2];
#pragma unroll
    for (int j = 0; j < 4; ++j) {
        wn[j] = *(const f32x4*)(a.norm_mix_pre + 256 * j + 4 * lane);
#pragma unroll
        for (int e = 0; e < 4; ++e) { const float* wp = a.w_in + (size_t)(256 * j + 4 * lane + e) * LDW_IN + NP; wd[j][e][0] = *(const f32x4*)wp; wd[j][e][1] = *(const f32x4*)(wp + 4); }
    }
    const int hsel = (lane & 1) * 4 + (lane & 2) + ((lane >> 2) & 1);
    const float dtb = a.dt_bias[hsel];
    const bool b0 = lane & 1, b1 = lane & 2, b2 = lane & 4;
    f32x4 v[4], vn[4], vnn[4];
#pragma unroll
    for (int j = 0; j < 4; ++j) { vn[j] = (f32x4){0.f, 0.f, 0.f, 0.f}; vnn[j] = vn[j]; }
    if (gw < T) {
        const f32x4* xr = (const f32x4*)(a.x + (size_t)gw * DM) + lane;
#pragma unroll
        for (int j = 0; j < 4; ++j) vn[j] = __builtin_nontemporal_load(xr + 64 * j);
    }
    if (gw + NGW < T) {
        const f32x4* xr = (const f32x4*)(a.x + (size_t)(gw + NGW) * DM) + lane;
#pragma unroll
        for (int j = 0; j < 4; ++j) vnn[j] = __builtin_nontemporal_load(xr + 64 * j);
    }
    for (int m = gw; m < T; m += NGW) {
#pragma unroll
        for (int j = 0; j < 4; ++j) { v[j] = vn[j]; vn[j] = vnn[j]; }
        if (m + 2 * NGW < T) {
            const f32x4* xr = (const f32x4*)(a.x + (size_t)(m + 2 * NGW) * DM) + lane;
#pragma unroll
            for (int j = 0; j < 4; ++j) vnn[j] = __builtin_nontemporal_load(xr + 64 * j);
        }
        float s = 0.f;
#pragma unroll
        for (int j = 0; j < 4; ++j) s += (v[j].x * v[j].x + v[j].y * v[j].y) + (v[j].z * v[j].z + v[j].w * v[j].w);
        const float r = __builtin_amdgcn_rsqf(wave_sum(s) * (1.f / DM) + EPS);
        f32x4 a0 = (f32x4){0.f, 0.f, 0.f, 0.f}, a1 = a0;
        unsigned long long* o8 = (unsigned long long*)(H + (size_t)m * DM) + lane;
#pragma unroll
        for (int j = 0; j < 4; ++j) {
            v[j] = v[j] * r * wn[j];
            o8[64 * j] = (unsigned long long)cvt_pk(v[j].x, v[j].y) | ((unsigned long long)cvt_pk(v[j].z, v[j].w) << 32);
#pragma unroll
            for (int e = 0; e < 4; ++e) { a0 += wd[j][e][0] * v[j][e]; a1 += wd[j][e][1] * v[j][e]; }
        }
        float c0, c1, c2, c3;
        { const f32x4 snd = b0 ? a0 : a1, kp = b0 ? a1 : a0;
          c0 = kp.x + __shfl_xor(snd.x, 1); c1 = kp.y + __shfl_xor(snd.y, 1); c2 = kp.z + __shfl_xor(snd.z, 1); c3 = kp.w + __shfl_xor(snd.w, 1); }
        float d0, d1;
        { const float s0 = b1 ? c0 : c2, s1 = b1 ? c1 : c3, k0 = b1 ? c2 : c0, k1 = b1 ? c3 : c1;
          d0 = k0 + __shfl_xor(s0, 2); d1 = k1 + __shfl_xor(s1, 2); }
        float e0;
        { const float s0 = b2 ? d0 : d1, k0 = b2 ? d1 : d0; e0 = k0 + __shfl_xor(s0, 4); }
        e0 += __shfl_xor(e0, 8); e0 += __shfl_xor(e0, 16); e0 += __shfl_xor(e0, 32);
        if (lane < 8) DT[(size_t)m * 8 + hsel] = softplus_f(e0 + dtb);
    }
}

constexpr int RS = 272;
constexpr int L_CL = 0, L_BS = 34816, L_BT = 69632, L_XT = 104448, L_SB = 121856, L_SM = 139264;
#define MFMA16(a, b, c) __builtin_amdgcn_mfma_f32_16x16x32_bf16((a), (b), (c), 0, 0, 0)
#define FRAG(base, row, kel) (*(const LAS bf16x8*)((base) + (row) * RS + (kel) * 2))

__device__ __forceinline__ void phase_conv(const Args& a, int tid, int G) {
    const bf16* P = (const bf16*)(a.ws + WS_P); bf16* XBC = (bf16*)(a.ws + WS_XBC);
    constexpr int RPT = 16, NTASK = (T / RPT) * 128;
    for (int task = blockIdx.x * NTHR + tid; task < NTASK; task += G * NTHR) {
        const int cg8 = task & 127, rb = task >> 7, chan = cg8 * 8, row0 = rb * RPT, tl0 = row0 & (SEQ - 1);
        float cw[4][8], cb[8];
#pragma unroll
        for (int k = 0; k < 4; ++k) { const f32x4 w0 = *(const f32x4*)(a.conv_w + k * 1024 + chan), w1 = *(const f32x4*)(a.conv_w + k * 1024 + chan + 4);
            cw[k][0] = w0.x; cw[k][1] = w0.y; cw[k][2] = w0.z; cw[k][3] = w0.w; cw[k][4] = w1.x; cw[k][5] = w1.y; cw[k][6] = w1.z; cw[k][7] = w1.w; }
        { const f32x4 b0 = *(const f32x4*)(a.conv_b + chan), b1 = *(const f32x4*)(a.conv_b + chan + 4);
            cb[0] = b0.x; cb[1] = b0.y; cb[2] = b0.z; cb[3] = b0.w; cb[4] = b1.x; cb[5] = b1.y; cb[6] = b1.z; cb[7] = b1.w; }
        u32x4 raw[RPT + 3];
#pragma unroll
        for (int i = 0; i < RPT + 3; ++i) raw[i] = (tl0 - 3 + i >= 0) ? __builtin_nontemporal_load((const u32x4*)(P + (size_t)(row0 - 3 + i) * NP + C_X + chan)) : (u32x4){0u, 0u, 0u, 0u};
#pragma unroll
        for (int r = 0; r < RPT; ++r) {
            float v[8];
#pragma unroll
            for (int e = 0; e < 8; ++e) {
                float s = cb[e];
#pragma unroll
                for (int k = 0; k < 4; ++k) { const unsigned wd = raw[r + k][e >> 1]; s += cw[k][e] * ((e & 1) ? bf_hi(wd) : bf_lo(wd)); }
                v[e] = silu_f(s);
            }
            u32x4 o; o.x = cvt_pk(v[0], v[1]); o.y = cvt_pk(v[2], v[3]); o.z = cvt_pk(v[4], v[5]); o.w = cvt_pk(v[6], v[7]);
            *(u32x4*)(XBC + (size_t)(row0 + r) * 1024 + chan) = o;
        }
    }
}

typedef short s16x4 __attribute__((ext_vector_type(4)));
__device__ __forceinline__ bf16x8 tr_frag(const LAS unsigned char* lanebase, int offA, int offB) {
    const s16x4 x = __builtin_amdgcn_ds_read_tr16_b64_v4i16((LAS s16x4*)(lanebase + offA));
    const s16x4 y = __builtin_amdgcn_ds_read_tr16_b64_v4i16((LAS s16x4*)(lanebase + offB));
    return (bf16x8){x[0], x[1], x[2], x[3], y[0], y[1], y[2], y[3]};
}
constexpr int XS_RS = 144;

__device__ __forceinline__ void gmlp_items(const Args& a, LAS unsigned char* lds, int first, int step, int tid, int lane, int wave) {
    const bf16* P = (const bf16*)(a.ws + WS_P); bf16* MIX = (bf16*)(a.ws + WS_MIX); const bf16* Wsb = (const bf16*)(a.ws + WS_WS);
    constexpr int NITEM = NB * NCH * 8;
    LAS unsigned char* VS = lds;
    const int s = tid >> 2, q = tid & 3;
    const int fr = lane & 15, fq = lane >> 4, w = wave;
    const int h = first & 7, tl = 16 * w + fr;
    const LAS unsigned char* vtr = VS + (8 * fq + ((lane & 15) >> 2)) * XS_RS + 8 * (lane & 3);
    float lw[16], lb[16];
#pragma unroll
    for (int i = 0; i < 4; ++i) { const f32x4 w4 = *(const f32x4*)(a.gm_ln_w + h * 64 + q * 16 + 4 * i), b4 = *(const f32x4*)(a.gm_ln_b + h * 64 + q * 16 + 4 * i);
        lw[4 * i] = w4.x; lw[4 * i + 1] = w4.y; lw[4 * i + 2] = w4.z; lw[4 * i + 3] = w4.w; lb[4 * i] = b4.x; lb[4 * i + 1] = b4.y; lb[4 * i + 2] = b4.z; lb[4 * i + 3] = b4.w; }
    bf16x8 af[4];
    const bf16* wrow = Wsb + ((size_t)h * 128 + 16 * w + fr) * 128 + fq * 8;
#pragma unroll
    for (int kk = 0; kk < 4; ++kk) af[kk] = (kk <= (w >> 1)) ? *(const bf16x8*)(wrow + kk * 32) : (bf16x8){0, 0, 0, 0, 0, 0, 0, 0};
    const float bs = a.gm_b_s[h * 128 + tl];
    u32x4 r0 = (u32x4){0u, 0u, 0u, 0u}, r1 = r0;
    if (first < NITEM) { const u32x4* src = (const u32x4*)(P + ((size_t)(first >> 3) * CHK + s) * NP + C_V + h * 64 + q * 16); r0 = __builtin_nontemporal_load(src); r1 = __builtin_nontemporal_load(src + 1); }
    __builtin_amdgcn_s_waitcnt(0);
    for (int item = first; item < NITEM; item += step) {
        const size_t t0 = (size_t)(item >> 3) * CHK; const size_t t = t0 + tl;
        u32x2 uu[4];
#pragma unroll
        for (int nt = 0; nt < 4; ++nt) uu[nt] = __builtin_nontemporal_load((const u32x2*)(P + t * NP + C_U + h * 64 + 16 * nt + fq * 4));
        float v[16];
        v[0] = bf_lo(r0.x); v[1] = bf_hi(r0.x); v[2] = bf_lo(r0.y); v[3] = bf_hi(r0.y); v[4] = bf_lo(r0.z); v[5] = bf_hi(r0.z); v[6] = bf_lo(r0.w); v[7] = bf_hi(r0.w);
        v[8] = bf_lo(r1.x); v[9] = bf_hi(r1.x); v[10] = bf_lo(r1.y); v[11] = bf_hi(r1.y); v[12] = bf_lo(r1.z); v[13] = bf_hi(r1.z); v[14] = bf_lo(r1.w); v[15] = bf_hi(r1.w);
        float sm = 0.f;
#pragma unroll
        for (int i = 0; i < 16; ++i) { v[i] = gelu_tanh(v[i]); sm += v[i]; }
        sm += __shfl_xor(sm, 1); sm += __shfl_xor(sm, 2);
        const float mu = sm * (1.f / 64.f); float sq = 0.f;
#pragma unroll
        for (int i = 0; i < 16; ++i) { v[i] -= mu; sq += v[i] * v[i]; }
        sq += __shfl_xor(sq, 1); sq += __shfl_xor(sq, 2);
        const float rstd = __builtin_amdgcn_rsqf(sq * (1.f / 64.f) + EPS);
#pragma unroll
        for (int i = 0; i < 16; ++i) v[i] = v[i] * rstd * lw[i] + lb[i];
        LBAR();
        { u32x4 o0, o1; o0.x = cvt_pk(v[0], v[1]); o0.y = cvt_pk(v[2], v[3]); o0.z = cvt_pk(v[4], v[5]); o0.w = cvt_pk(v[6], v[7]);
          o1.x = cvt_pk(v[8], v[9]); o1.y = cvt_pk(v[10], v[11]); o1.z = cvt_pk(v[12], v[13]); o1.w = cvt_pk(v[14], v[15]);
          LAS u32x4* dst = (LAS u32x4*)(VS + s * XS_RS + q * 32); dst[0] = o0; dst[1] = o1; }
        { const int nx = item + step; if (nx < NITEM) { const u32x4* src = (const u32x4*)(P + ((size_t)(nx >> 3) * CHK + s) * NP + C_V + h * 64 + q * 16); r0 = __builtin_nontemporal_load(src); r1 = __builtin_nontemporal_load(src + 1); } }
        LBAR();
        f32x4 acc[4];
#pragma unroll
        for (int nt = 0; nt < 4; ++nt) acc[nt] = (f32x4){0.f, 0.f, 0.f, 0.f};
#pragma unroll
        for (int kk = 0; kk < 4; ++kk) {
            if (kk <= (w >> 1)) {
                bf16x8 vfr[4];
#pragma unroll
                for (int nt = 0; nt < 4; ++nt) vfr[nt] = tr_frag(vtr, (32 * kk) * XS_RS + 32 * nt, (32 * kk + 4) * XS_RS + 32 * nt);
                __builtin_amdgcn_sched_barrier(0);
#pragma unroll
                for (int nt = 0; nt < 4; ++nt) acc[nt] = MFMA16(vfr[nt], af[kk], acc[nt]);
                __builtin_amdgcn_sched_barrier(0);
            }
        }
#pragma unroll
        for (int nt = 0; nt < 4; ++nt) {
            const int col = h * 64 + 16 * nt + fq * 4;
            const float o0 = gelu_tanh(bf_lo(uu[nt].x)) * (acc[nt][0] + bs), o1 = gelu_tanh(bf_hi(uu[nt].x)) * (acc[nt][1] + bs);
            const float o2 = gelu_tanh(bf_lo(uu[nt].y)) * (acc[nt][2] + bs), o3 = gelu_tanh(bf_hi(uu[nt].y)) * (acc[nt][3] + bs);
            u32x2 o; o.x = cvt_pk(o0, o1); o.y = cvt_pk(o2, o3);
            *(u32x2*)(MIX + t * DM + col) = o;
        }
    }
}

template <int W>
__device__ __forceinline__ void ssd_cb_ydiag(u32x2 (&gq)[8], f32x4 (&accY)[4], const bf16x8 (&cf)[4], const LAS unsigned char* BS, const LAS unsigned char* xtr_prm,
                                             const LAS float* acs, const LAS float* esd, const LAS float* dtv, float acl, int l, int fr, int fq) {
    constexpr int NO = W > 0 ? W : 1;
    f32x4 cbv[W + 1];
#pragma unroll
    for (int j = 0; j <= W; ++j) cbv[j] = (f32x4){0.f, 0.f, 0.f, 0.f};
#pragma unroll
    for (int kk = 0; kk < 4; ++kk)
    {
        bf16x8 bfr[W + 1];
#pragma unroll
        for (int j = 0; j <= W; ++j) bfr[j] = FRAG(BS, 16 * j + fr, kk * 32 + fq * 8);
        __builtin_amdgcn_sched_barrier(0);
#pragma unroll
        for (int j = 0; j <= W; ++j) cbv[j] = MFMA16(bfr[j], cf[kk], cbv[j]);
        __builtin_amdgcn_sched_barrier(0);
    }
    float refv[NO]; f32x4 e4[NO];
#pragma unroll
    for (int j = 0; j < W; ++j) { refv[j] = acs[16 * j + 15]; e4[j] = *(const LAS f32x4*)(esd + 16 * j + fq * 4); }
    const f32x4 as4 = *(const LAS f32x4*)(acs + 16 * W + fq * 4), dt4 = *(const LAS f32x4*)(dtv + 16 * W + fq * 4);
    __builtin_amdgcn_sched_barrier(0);
    constexpr int NK = W / 2 + 1;
#pragma unroll
    for (int j = 0; j < 8; ++j) gq[j] = (u32x2){0u, 0u};
#pragma unroll
    for (int j = 0; j < W; ++j) {
        const float el = __expf(acl - refv[j]);
        const f32x4 gv = cbv[j] * el * e4[j];
        gq[j].x = cvt_pk(gv[0], gv[1]); gq[j].y = cvt_pk(gv[2], gv[3]);
    }
    {
        const int s0 = 16 * W + fq * 4; float gv[4];
#pragma unroll
        for (int r = 0; r < 4; ++r) { const float dec = __expf(fminf(acl - as4[r], 0.f)); gv[r] = (s0 + r <= l) ? cbv[W][r] * dec * dt4[r] : 0.f; }
        gq[W].x = cvt_pk(gv[0], gv[1]); gq[W].y = cvt_pk(gv[2], gv[3]);
    }
#pragma unroll
    for (int kk = 0; kk < NK; ++kk) {
        union { u32x4 u; bf16x8 v; } gf; gf.u = (u32x4){gq[2 * kk].x, gq[2 * kk].y, gq[2 * kk + 1].x, gq[2 * kk + 1].y};
        {
            bf16x8 xfr[4];
#pragma unroll
            for (int nt = 0; nt < 4; ++nt) xfr[nt] = tr_frag(xtr_prm, (32 * kk) * XS_RS + 32 * nt, (32 * kk + 16) * XS_RS + 32 * nt);
            __builtin_amdgcn_sched_barrier(0);
#pragma unroll
            for (int nt = 0; nt < 4; ++nt) accY[nt] = MFMA16(xfr[nt], gf.v, accY[nt]);
            __builtin_amdgcn_sched_barrier(0);
        }
    }
}

constexpr int L2_CL = 0, L2_BS = 34816, L2_XS = 69632, L2_SB = 88064, L2_SM = 105472;
__device__ __forceinline__ void ssd_item(const Args& a, LAS unsigned char* lds, int item, int tid, int lane, int wave) {
    const bf16* P = (const bf16*)(a.ws + WS_P); const bf16* XBC = (const bf16*)(a.ws + WS_XBC); bf16* MIX = (bf16*)(a.ws + WS_MIX);
    const float* DT = (const float*)(a.ws + WS_DT); float* SSQ = (float*)(a.ws + WS_SSQ);
    const int h = item & 7, b = item >> 3, g = h >> 2;
    const int fr = lane & 15, fq = lane >> 4, w = wave;
    LAS unsigned char* CL = lds + L2_CL; LAS unsigned char* BS = lds + L2_BS; LAS unsigned char* XS = lds + L2_XS; LAS unsigned char* SB = lds + L2_SB;
    LAS float* tabs = (LAS float*)(lds + L2_SM);
    const float A = -__expf(a.a_log[h]); const float dsk = a.d_skip[h];
    f32x4 accS[4];
#pragma unroll
    for (int i = 0; i < 4; ++i) accS[i] = (f32x4){0.f, 0.f, 0.f, 0.f};
    const int pt = w >> 1, nb0 = (w & 1) * 4;
    const int trq = (lane & 15) >> 2, trp = lane & 3;
    const LAS unsigned char* xtr_std = XS + (8 * fq + trq) * XS_RS + 8 * trp;
    const LAS unsigned char* xtr_prm = XS + (4 * fq + trq) * XS_RS + 8 * trp;
    const LAS unsigned char* btr_std = BS + (8 * fq + trq) * RS + 8 * trp;
    u32x4 rc[4], rb_[4], rx[2];
#define SSD_LOADS(cc) do { const size_t tb_ = (size_t)b * SEQ + (size_t)(cc) * CHK; \
        _Pragma("unroll") for (int i_ = 0; i_ < 4; ++i_) { const int idx_ = tid + 512 * i_; const bf16* rp_ = XBC + (tb_ + (idx_ >> 4)) * 1024 + g * 128 + (idx_ & 15) * 8; rb_[i_] = *(const u32x4*)(rp_ + 512); } \
        _Pragma("unroll") for (int k_ = 0; k_ < 4; ++k_) rc[k_] = *(const u32x4*)(XBC + (tb_ + 16 * w + fr) * 1024 + 768 + g * 128 + k_ * 32 + fq * 8); \
        _Pragma("unroll") for (int i_ = 0; i_ < 2; ++i_) { const int idx_ = tid + 512 * i_; rx[i_] = __builtin_nontemporal_load((const u32x4*)(XBC + (tb_ + (idx_ >> 3)) * 1024 + h * 64 + (idx_ & 7) * 8)); } \
        } while (0)
    SSD_LOADS(0);
    {
        float dd[2][2];
#pragma unroll
        for (int k = 0; k < 2; ++k) { const size_t tb = (size_t)b * SEQ + (size_t)(2 * w + k) * CHK; dd[k][0] = DT[(tb + lane) * 8 + h]; dd[k][1] = DT[(tb + 64 + lane) * 8 + h]; }
#pragma unroll
        for (int k = 0; k < 2; ++k) {
            LAS float* acs = tabs + (2 * w + k) * 640; LAS float* esd = acs + 128; LAS float* wgt = acs + 256; LAS float* eacs = acs + 384; LAS float* dtv = acs + 512;
            const float d0 = dd[k][0], d1 = dd[k][1];
            float s0 = d0 * A, s1 = d1 * A;
#pragma unroll
            for (int o = 1; o < 64; o <<= 1) { const float u0 = __shfl_up(s0, o), u1 = __shfl_up(s1, o); if (lane >= o) { s0 += u0; s1 += u1; } }
            s1 += __shfl(s0, 63);
            const float aend = __shfl(s1, 63);
            const float rf0 = __shfl(s0, lane | 15), rf1 = __shfl(s1, lane | 15);
            acs[lane] = s0; acs[64 + lane] = s1; dtv[lane] = d0; dtv[64 + lane] = d1;
            esd[lane] = d0 * __expf(rf0 - s0); esd[64 + lane] = d1 * __expf(rf1 - s1);
            wgt[lane] = d0 * __expf(aend - s0); wgt[64 + lane] = d1 * __expf(aend - s1);
            eacs[lane] = __expf(s0); eacs[64 + lane] = __expf(s1);
        }
    }
    __builtin_amdgcn_s_waitcnt(0);
    for (int c = 0; c < NCH; ++c) {
        const size_t t0 = (size_t)b * SEQ + (size_t)c * CHK;
        LBAR();
#pragma unroll
        for (int i = 0; i < 4; ++i) { u32x2 o; o.x = cvt_pk(accS[i][0], accS[i][1]); o.y = cvt_pk(accS[i][2], accS[i][3]);
            *(LAS u32x2*)(SB + (16 * pt + fr) * RS + (16 * (nb0 + i) + fq * 4) * 2) = o; }
        const LAS float* acs = tabs + c * 640; const LAS float* esd = acs + 128; const LAS float* wgt = acs + 256; const LAS float* eacs = acs + 384; const LAS float* dtv = acs + 512;
#pragma unroll
        for (int i = 0; i < 4; ++i) { const int idx = tid + 512 * i; *(LAS u32x4*)(BS + (idx >> 4) * RS + (idx & 15) * 16) = rb_[i]; }
#pragma unroll
        for (int i = 0; i < 2; ++i) { const int idx = tid + 512 * i; *(LAS u32x4*)(XS + (idx >> 3) * XS_RS + (idx & 7) * 16) = rx[i]; }
        bf16x8 cf[4];
#pragma unroll
        for (int kk = 0; kk < 4; ++kk) { union { u32x4 u; bf16x8 v; } cv; cv.u = rc[kk]; cf[kk] = cv.v; }
        if (c + 1 < NCH) SSD_LOADS(c + 1);
        LBAR();
        const int l = 16 * w + fr; const size_t t = t0 + l;
        u32x2 zz[4];
#pragma unroll
        for (int nt = 0; nt < 4; ++nt) zz[nt] = __builtin_nontemporal_load((const u32x2*)(P + t * NP + C_Z + h * 64 + 16 * nt + fq * 4));
        const float acl = acs[l];
        u32x2 gq[8];
        f32x4 accY[4];
#pragma unroll
        for (int nt = 0; nt < 4; ++nt) accY[nt] = (f32x4){0.f, 0.f, 0.f, 0.f};
        switch (w) {
            case 0: ssd_cb_ydiag<0>(gq, accY, cf, BS, xtr_prm, acs, esd, dtv, acl, l, fr, fq); break;
            case 1: ssd_cb_ydiag<1>(gq, accY, cf, BS, xtr_prm, acs, esd, dtv, acl, l, fr, fq); break;
            case 2: ssd_cb_ydiag<2>(gq, accY, cf, BS, xtr_prm, acs, esd, dtv, acl, l, fr, fq); break;
            case 3: ssd_cb_ydiag<3>(gq, accY, cf, BS, xtr_prm, acs, esd, dtv, acl, l, fr, fq); break;
            case 4: ssd_cb_ydiag<4>(gq, accY, cf, BS, xtr_prm, acs, esd, dtv, acl, l, fr, fq); break;
            case 5: ssd_cb_ydiag<5>(gq, accY, cf, BS, xtr_prm, acs, esd, dtv, acl, l, fr, fq); break;
            case 6: ssd_cb_ydiag<6>(gq, accY, cf, BS, xtr_prm, acs, esd, dtv, acl, l, fr, fq); break;
            default: ssd_cb_ydiag<7>(gq, accY, cf, BS, xtr_prm, acs, esd, dtv, acl, l, fr, fq); break;
        }
        f32x4 accO[4];
#pragma unroll
        for (int nt = 0; nt < 4; ++nt) accO[nt] = (f32x4){0.f, 0.f, 0.f, 0.f};
        if (c > 0) {
#pragma unroll
            for (int kk = 0; kk < 4; kk += 2) {
                bf16x8 sfr[2][4];
#pragma unroll
                for (int k2 = 0; k2 < 2; ++k2)
#pragma unroll
                    for (int nt = 0; nt < 4; ++nt) sfr[k2][nt] = FRAG(SB, 16 * nt + fr, (kk + k2) * 32 + fq * 8);
                __builtin_amdgcn_sched_barrier(0);
#pragma unroll
                for (int k2 = 0; k2 < 2; ++k2)
#pragma unroll
                    for (int nt = 0; nt < 4; ++nt) accO[nt] = MFMA16(sfr[k2][nt], cf[kk + k2], accO[nt]);
                __builtin_amdgcn_sched_barrier(0);
            }
        }
        {
            const float ea = eacs[l]; float ssq = 0.f;
#pragma unroll
            for (int nt = 0; nt < 4; ++nt) {
                const int p0 = 16 * nt + fq * 4;
                const u32x2 xx = *(const LAS u32x2*)(XS + l * XS_RS + p0 * 2);
                const float xv[4] = {bf_lo(xx.x), bf_hi(xx.x), bf_lo(xx.y), bf_hi(xx.y)};
                const float zv[4] = {bf_lo(zz[nt].x), bf_hi(zz[nt].x), bf_lo(zz[nt].y), bf_hi(zz[nt].y)};
                float yo[4];
#pragma unroll
                for (int r = 0; r < 4; ++r) {
                    float y = accY[nt][r] + ea * accO[nt][r] + dsk * xv[r];
                    y *= silu_f(zv[r]); ssq += y * y; yo[r] = y;
                }
                u32x2 o; o.x = cvt_pk(yo[0], yo[1]); o.y = cvt_pk(yo[2], yo[3]);
                *(u32x2*)(MIX + t * DM + 512 + h * 64 + p0) = o;
            }
            ssq += __shfl_xor(ssq, 16); ssq += __shfl_xor(ssq, 32);
            if (fq == 0) SSQ[t * 8 + h] = ssq;
        }
        if (c + 1 < NCH) {
            const float cd = eacs[127];
#pragma unroll
            for (int i = 0; i < 4; ++i) accS[i] = accS[i] * cd;
#pragma unroll
            for (int kk = 0; kk < 4; ++kk) {
                bf16x8 bfr[4];
#pragma unroll
                for (int i = 0; i < 4; ++i) bfr[i] = tr_frag(btr_std + 32 * nb0, (32 * kk) * RS + 32 * i, (32 * kk + 4) * RS + 32 * i);
                union { u32x4 u; bf16x8 v; } xf; xf.v = tr_frag(xtr_std + 32 * pt, (32 * kk) * XS_RS, (32 * kk + 4) * XS_RS);
                const f32x4 w0 = *(const LAS f32x4*)(wgt + kk * 32 + fq * 8), w1 = *(const LAS f32x4*)(wgt + kk * 32 + fq * 8 + 4);
                xf.u.x = cvt_pk(bf_lo(xf.u.x) * w0.x, bf_hi(xf.u.x) * w0.y); xf.u.y = cvt_pk(bf_lo(xf.u.y) * w0.z, bf_hi(xf.u.y) * w0.w);
                xf.u.z = cvt_pk(bf_lo(xf.u.z) * w1.x, bf_hi(xf.u.z) * w1.y); xf.u.w = cvt_pk(bf_lo(xf.u.w) * w1.z, bf_hi(xf.u.w) * w1.w);
#pragma unroll
                for (int i = 0; i < 4; ++i) accS[i] = MFMA16(bfr[i], xf.v, accS[i]);
                __builtin_amdgcn_sched_barrier(0);
            }
        }
    }
#undef SSD_LOADS
}

__device__ __forceinline__ void convert_late_weights(const Args& a, LAS unsigned char* lds, int first_wave, int nwaves, int lane, int wave) {
    bf16* Wout_t = (bf16*)(a.ws + WS_WOUT); bf16* Wup_t = (bf16*)(a.ws + WS_WUP); bf16* Wdn_t = (bf16*)(a.ws + WS_WDN);
    LAS float* scr = (LAS float*)(lds + wave * 16384);
    constexpr int I_OUT = (DM / 64) * (DM / 32), I_UP = (DM / 64) * (FF / 32), I_DN = (FF / 64) * (DM / 32);
    for (int it = first_wave; it < I_OUT + I_UP + I_DN; it += nwaves) {
        int r = it;
        if (r < I_OUT) { p0_transpose_item(a.w_out, DM, DM / 32, DM, Wout_t, scr, r, lane, a.ssm_norm_w, 512); continue; } r -= I_OUT;
        if (r < I_UP) { p0_transpose_item(a.w_up, DM, FF / 32, FF, Wup_t, scr, r, lane); continue; } r -= I_UP;
        p0_transpose_item(a.w_down, FF, DM / 32, DM, Wdn_t, scr, r, lane);
    }
}

__device__ __forceinline__ void phase_mixer(const Args& a, LAS unsigned char* lds, int tid, int lane, int wave, int G) {
    const int half = G / 2, bx = blockIdx.x;
    if (bx < half) {
        for (int it = bx; it < NB * 8; it += half) {
            int item = it;
            if (half == 128) { const int x = it & 7, k = it >> 3, pair = x * 4 + (k >> 2), r = k & 3; item = (pair >> 1) * 8 + (pair & 1) * 4 + r; }
            ssd_item(a, lds, item, tid, lane, wave);
        }
    }
    else { gmlp_items(a, lds, bx - half, G - half, tid, lane, wave); LBAR(); convert_late_weights(a, lds, (bx - half) * NWAVES + wave, (G - half) * NWAVES, lane, wave); }
}

__device__ __forceinline__ void phase_fixup(const Args& a, int lane, int wave, int G) {
    bf16* MIX = (bf16*)(a.ws + WS_MIX); const float* SSQ = (const float*)(a.ws + WS_SSQ);
    const int gw = blockIdx.x * NWAVES + wave, NGW = G * NWAVES;
    for (int m = gw; m < T; m += NGW) {
        const f32x4 q = *(const f32x4*)(SSQ + (size_t)m * 8 + (lane >> 5) * 4);
        const float sc = 1.0f / sqrtf(((q.x + q.y) + (q.z + q.w)) * (1.f / 256.f) + EPS);
        u32x4* p = (u32x4*)(MIX + (size_t)m * DM + 512) + lane;
        u32x4 v = *p;
        v.x = cvt_pk(bf_lo(v.x) * sc, bf_hi(v.x) * sc); v.y = cvt_pk(bf_lo(v.y) * sc, bf_hi(v.y) * sc);
        v.z = cvt_pk(bf_lo(v.z) * sc, bf_hi(v.z) * sc); v.w = cvt_pk(bf_lo(v.w) * sc, bf_hi(v.w) * sc);
        *p = v;
    }
}

__device__ __forceinline__ void phase_norm1(const Args& a, int lane, int wave, int G) {
    const bf16* OB = (const bf16*)(a.ws + WS_DN); bf16* X1B = (bf16*)(a.ws + WS_X1B); bf16* H = (bf16*)(a.ws + WS_H);
    const int gw = blockIdx.x * NWAVES + wave, NGW = G * NWAVES;
    f32x4 wp[4], wf[4];
#pragma unroll
    for (int j = 0; j < 4; ++j) { wp[j] = *(const f32x4*)(a.norm_mix_post + 256 * j + 4 * lane); wf[j] = *(const f32x4*)(a.norm_ffn_pre + 256 * j + 4 * lane); }
    u32x2 o[4], on[4], onn[4]; f32x4 x[4], xn[4], xnn[4];
#pragma unroll
    for (int j = 0; j < 4; ++j) { on[j] = (u32x2){0u, 0u}; onn[j] = on[j]; xn[j] = (f32x4){0.f, 0.f, 0.f, 0.f}; xnn[j] = xn[j]; }
#define N1_LOAD(dst_o, dst_x, row) do { const u32x2* op_ = (const u32x2*)(OB + (size_t)(row) * DM) + lane; const f32x4* xp_ = (const f32x4*)(a.x + (size_t)(row) * DM) + lane; \
        _Pragma("unroll") for (int j_ = 0; j_ < 4; ++j_) { dst_o[j_] = __builtin_nontemporal_load(op_ + 64 * j_); dst_x[j_] = __builtin_nontemporal_load(xp_ + 64 * j_); } } while (0)
    if (gw < T) N1_LOAD(on, xn, gw);
    if (gw + NGW < T) N1_LOAD(onn, xnn, gw + NGW);
    for (int m = gw; m < T; m += NGW) {
#pragma unroll
        for (int j = 0; j < 4; ++j) { o[j] = on[j]; x[j] = xn[j]; on[j] = onn[j]; xn[j] = xnn[j]; }
        if (m + 2 * NGW < T) N1_LOAD(onn, xnn, m + 2 * NGW);
        f32x4 v[4]; float s = 0.f;
#pragma unroll
        for (int j = 0; j < 4; ++j) { v[j] = (f32x4){bf_lo(o[j].x), bf_hi(o[j].x), bf_lo(o[j].y), bf_hi(o[j].y)}; s += (v[j].x * v[j].x + v[j].y * v[j].y) + (v[j].z * v[j].z + v[j].w * v[j].w); }
        const float r = __builtin_amdgcn_rsqf(wave_sum(s) * (1.f / DM) + EPS);
        float s2 = 0.f;
        u32x2* xo = (u32x2*)(X1B + (size_t)m * DM) + lane;
#pragma unroll
        for (int j = 0; j < 4; ++j) { v[j] = x[j] + v[j] * r * wp[j]; u32x2 w; w.x = cvt_pk(v[j].x, v[j].y); w.y = cvt_pk(v[j].z, v[j].w); __builtin_nontemporal_store(w, xo + 64 * j);
            s2 += (v[j].x * v[j].x + v[j].y * v[j].y) + (v[j].z * v[j].z + v[j].w * v[j].w); }
        const float r2 = __builtin_amdgcn_rsqf(wave_sum(s2) * (1.f / DM) + EPS);
        u32x2* ho = (u32x2*)(H + (size_t)m * DM) + lane;
#pragma unroll
        for (int j = 0; j < 4; ++j) { const f32x4 hv = v[j] * r2 * wf[j]; u32x2 w; w.x = cvt_pk(hv.x, hv.y); w.y = cvt_pk(hv.z, hv.w); ho[64 * j] = w; }
    }
#undef N1_LOAD
}

__device__ __forceinline__ void phase_norm2(const Args& a, int lane, int wave, int G) {
    const bf16* DN = (const bf16*)(a.ws + WS_DN); const bf16* X1B = (const bf16*)(a.ws + WS_X1B);
    const int gw = blockIdx.x * NWAVES + wave, NGW = G * NWAVES;
    f32x4 wp[4];
#pragma unroll
    for (int j = 0; j < 2; ++j) { wp[2 * j] = *(const f32x4*)(a.norm_ffn_post + 512 * j + 8 * lane); wp[2 * j + 1] = *(const f32x4*)(a.norm_ffn_post + 512 * j + 8 * lane + 4); }
    u32x4 d[2], x[2], dn[2], xn[2], dnn[2], xnn[2];
#pragma unroll
    for (int j = 0; j < 2; ++j) { dn[j] = (u32x4){0u, 0u, 0u, 0u}; xn[j] = dn[j]; dnn[j] = dn[j]; xnn[j] = dn[j]; }
#define N2_LOAD(dst_d, dst_x, row) do { const u32x4* dp_ = (const u32x4*)(DN + (size_t)(row) * DM) + lane; const u32x4* xp_ = (const u32x4*)(X1B + (size_t)(row) * DM) + lane; \
        dst_d[0] = __builtin_nontemporal_load(dp_); dst_d[1] = __builtin_nontemporal_load(dp_ + 64); dst_x[0] = __builtin_nontemporal_load(xp_); dst_x[1] = __builtin_nontemporal_load(xp_ + 64); } while (0)
    if (gw < T) N2_LOAD(dn, xn, gw);
    if (gw + NGW < T) N2_LOAD(dnn, xnn, gw + NGW);
    for (int m = gw; m < T; m += NGW) {
#pragma unroll
        for (int j = 0; j < 2; ++j) { d[j] = dn[j]; x[j] = xn[j]; dn[j] = dnn[j]; xn[j] = xnn[j]; }
        if (m + 2 * NGW < T) N2_LOAD(dnn, xnn, m + 2 * NGW);
        float dv[16], s = 0.f;
#pragma unroll
        for (int j = 0; j < 2; ++j)
#pragma unroll
            for (int k = 0; k < 4; ++k) { dv[8 * j + 2 * k] = bf_lo(d[j][k]); dv[8 * j + 2 * k + 1] = bf_hi(d[j][k]); }
#pragma unroll
        for (int i = 0; i < 16; ++i) s += dv[i] * dv[i];
        const float r = __builtin_amdgcn_rsqf(wave_sum(s) * (1.f / DM) + EPS);
        float* orow = a.out + (size_t)m * DM + 8 * lane;
#pragma unroll
        for (int j = 0; j < 2; ++j) {
            f32x4 o0, o1;
            o0.x = bf_lo(x[j].x) + dv[8 * j + 0] * r * wp[2 * j].x; o0.y = bf_hi(x[j].x) + dv[8 * j + 1] * r * wp[2 * j].y;
            o0.z = bf_lo(x[j].y) + dv[8 * j + 2] * r * wp[2 * j].z; o0.w = bf_hi(x[j].y) + dv[8 * j + 3] * r * wp[2 * j].w;
            o1.x = bf_lo(x[j].z) + dv[8 * j + 4] * r * wp[2 * j + 1].x; o1.y = bf_hi(x[j].z) + dv[8 * j + 5] * r * wp[2 * j + 1].y;
            o1.z = bf_lo(x[j].w) + dv[8 * j + 6] * r * wp[2 * j + 1].z; o1.w = bf_hi(x[j].w) + dv[8 * j + 7] * r * wp[2 * j + 1].w;
            __builtin_nontemporal_store(o0, (f32x4*)(orow + 512 * j)); __builtin_nontemporal_store(o1, (f32x4*)(orow + 512 * j + 4));
        }
    }
#undef N2_LOAD
}

constexpr int N_PHASES = 10;
__global__ void __launch_bounds__(NTHR, 2) fwd_megakernel(Args args) {
    extern __shared__ __attribute__((aligned(16))) unsigned char lds_raw[];
    LAS unsigned char* lds = (LAS unsigned char*)lds_raw;
    const int tid = threadIdx.x, lane = tid & 63, wave = __builtin_amdgcn_readfirstlane(tid >> 6), G = gridDim.x;
    const int lo = args.ph_lo, hi = args.ph_hi;
    unsigned char* ws = args.ws;
    volatile LAS unsigned* MISC = (volatile LAS unsigned*)(lds + MISC_OFF);
    if (tid < 32) MISC[tid] = 0u;
    __syncthreads();
#if MK_N_LAUNCHES == 1
    const XcdBarrier bar = xcd_barrier_post((unsigned*)(ws + WS_CTL), MISC + 8);
#endif
    bf16* Win_t = (bf16*)(ws + WS_WIN); bf16* Wout_t = (bf16*)(ws + WS_WOUT); bf16* Wup_t = (bf16*)(ws + WS_WUP); bf16* Wdn_t = (bf16*)(ws + WS_WDN);
    bf16* H = (bf16*)(ws + WS_H); bf16* P = (bf16*)(ws + WS_P); bf16* MIX = (bf16*)(ws + WS_MIX); bf16* F = (bf16*)(ws + WS_F); float* O = (float*)(ws + WS_O);
#define IN(k) (lo <= (k) && (k) < hi)
#if MK_N_LAUNCHES == 1
#define SEAM(k) do { if (IN(k) && IN((k) + 1)) { if (lo < 0) cg::this_grid().sync(); else xcd_barrier(bar); } } while (0)
#else
#define SEAM(k) do { } while (0)
#endif
    if (IN(0)) { phase_prologue(args, lds, tid, lane, wave, G); }
    SEAM(0);
    if (IN(1)) {
        __syncthreads();
        pg8::Gemm g{H, Win_t, T, NP, DM}; pg8::StaticOrder S; S.init(T, NP, G, (int)blockIdx.x);
        pg8::EpiBf16<0> E{P, NP, nullptr, 0, 0, 1.f};
        pg8::gemm_phase<pg8::EpiBf16<0>, pg8::StaticOrder, true, true>(lds, g, S, E);
    }
    SEAM(1);
    if (IN(2)) { phase_conv(args, tid, G); }
    SEAM(2);
    if (IN(3)) { phase_mixer(args, lds, tid, lane, wave, G); }
    SEAM(4);
    if (IN(5)) {
        __syncthreads();
        pg8::Gemm g{MIX, Wout_t, T, DM, DM}; pg8::StaticOrder S; S.init(T, DM, G, (int)blockIdx.x);
        pg8::EpiBf16K E{(bf16*)(ws + WS_DN), DM, (const float*)(ws + WS_SSQ), lds + 131072};
        pg8::gemm_phase<pg8::EpiBf16K, pg8::StaticOrder, true, true>(lds, g, S, E);
    }
    SEAM(5);
    if (IN(6)) { phase_norm1(args, lane, wave, G); }
    SEAM(6);
    if (IN(7)) {
        __syncthreads();
        pg8::Gemm g{H, Wup_t, T, FF, DM}; pg8::StaticOrder S; S.init(T, FF, G, (int)blockIdx.x);
        pg8::EpiBf16<2> E{F, FF, nullptr, 0, 0, 1.f};
        pg8::gemm_phase<pg8::EpiBf16<2>, pg8::StaticOrder, true, true>(lds, g, S, E);
    }
    SEAM(7);
    if (IN(8)) {
        __syncthreads();
        pg8::Gemm g{F, Wdn_t, T, DM, FF}; pg8::StaticOrder S; S.init(T, DM, G, (int)blockIdx.x);
        pg8::EpiBf16<0> E{(bf16*)(ws + WS_DN), DM, nullptr, 0, 0, 1.f};
        pg8::gemm_phase<pg8::EpiBf16<0>, pg8::StaticOrder, true, true>(lds, g, S, E);
    }
    SEAM(8);
    if (IN(9)) { phase_norm2(args, lane, wave, G); }
#undef IN
#undef SEAM
}

extern "C" void kernel_launch(void* const* d_in, const int* in_sizes, int n_in, void* d_out, int out_size, void* d_ws, size_t ws_size, hipStream_t stream) {
    static int grid = 0;
    if (grid == 0) {
        if (n_in != 19 || out_size != T * DM || ws_size < WS_END) { fprintf(stderr, "kernel_launch: unexpected sizes n_in %d out %d ws %zu\n", n_in, out_size, ws_size); grid = -1; return; }
        int dev = 0, cus = 0, per_cu = 0;
        (void)hipGetDevice(&dev); (void)hipDeviceGetAttribute(&cus, hipDeviceAttributeMultiprocessorCount, dev);
        if (hipFuncSetAttribute((const void*)fwd_megakernel, hipFuncAttributeMaxDynamicSharedMemorySize, LDS_BYTES) != hipSuccess) { fprintf(stderr, "kernel_launch: hipFuncSetAttribute failed\n"); grid = -1; return; }
        if (hipOccupancyMaxActiveBlocksPerMultiprocessor(&per_cu, (const void*)fwd_megakernel, NTHR, LDS_BYTES) != hipSuccess || per_cu < 1) { fprintf(stderr, "kernel_launch: occupancy query says %d\n", per_cu); per_cu = 1; }
        (void)hipGetLastError();
        grid = cus >= 256 ? 256 : (cus / 16) * 16;
        if (grid < 16) { fprintf(stderr, "kernel_launch: too few CUs (%d)\n", cus); grid = -1; return; }
        fprintf(stderr, "kernel_launch: grid %d (cus %d, per_cu %d)\n", grid, cus, per_cu);
    }
    if (grid < 0) return;
    Args a{};
    const float** ap = (const float**)&a;
    for (int i = 0; i < 19; ++i) ap[i] = (const float*)d_in[i];
    a.out = (float*)d_out; a.ws = (unsigned char*)d_ws;
#if MK_N_LAUNCHES == 1
    if (hipMemsetAsync((char*)d_ws + WS_CTL, 0, CTL_ZERO_BYTES, stream) != hipSuccess) { fprintf(stderr, "kernel_launch: memset failed\n"); return; }
    a.ph_lo = 0; a.ph_hi = N_PHASES;
    void* kargs[] = {&a};
    hipError_t e = hipLaunchCooperativeKernel((const void*)fwd_megakernel, dim3(grid), dim3(NTHR), kargs, LDS_BYTES, stream);
    if (e != hipSuccess) fprintf(stderr, "kernel_launch: cooperative launch failed: %s (grid %d)\n", hipGetErrorString(e), grid);
#else
    for (int ph = 0; ph < N_PHASES; ++ph) {
        a.ph_lo = ph; a.ph_hi = ph + 1;
        hipLaunchKernelGGL(fwd_megakernel, dim3(grid), dim3(NTHR), LDS_BYTES, stream, a);
    }
#endif
}
```
